# Optimizing an MI355X kernel written in HIP

```python
import math
import jax, jax.numpy as jnp
from jax import lax
import numpy as np

D_MODEL = 1024
BATCH = 8
SEQ = 2048
DEPTH = 2

N_HEADS = 16
HEAD_DIM = D_MODEL // N_HEADS
Q_BLOCK = 128
MOBA_BLOCK = 256
MOBA_TOPK = 3
N_BUCKETS = 32
MAX_DISTANCE = 128
D_FF = 2816
N_EXPERTS = 8
TOP_K = 2
D_FF_EXPERT = 3584
N_DENSE = (DEPTH + 1) // 2
N_MOE = DEPTH // 2
RMS_EPS = 1e-6
NEG_BIG = -1e30

kernel_name = 'hybrid_stickbreak_moba_moe_block'


def rmsnorm(x, g):
    xf = x.astype(jnp.float32)
    y = xf * lax.rsqrt(jnp.mean(xf * xf, axis=-1, keepdims=True) + RMS_EPS)
    return (y * g.astype(jnp.float32)).astype(x.dtype)


def t5_bucket(dist):
    n = jnp.maximum(dist, 0)
    max_exact = N_BUCKETS // 2
    nf = jnp.maximum(n, 1).astype(jnp.float32)
    large = max_exact + (jnp.log(nf / max_exact) / math.log(MAX_DISTANCE / max_exact)
                         * (N_BUCKETS - max_exact)).astype(jnp.int32)
    large = jnp.minimum(large, N_BUCKETS - 1)
    return jnp.where(n < max_exact, n, large)


def qkv_heads(h, w_qkv):
    b, s, d = h.shape
    qkv = jnp.einsum('bsd,de->bse', h, w_qkv)
    q, k, v = jnp.split(qkv, 3, axis=-1)
    to_heads = lambda t: t.reshape(b, s, N_HEADS, HEAD_DIM).transpose(0, 2, 1, 3)
    return to_heads(q), to_heads(k), to_heads(v)


def stick_breaking_attention(q, k, v):
    b, nh, s, dh = q.shape
    scale = dh ** -0.5
    k_pos = jnp.arange(s)

    def block(c):
        q0 = c * Q_BLOCK
        qc = lax.dynamic_slice_in_dim(q, q0, Q_BLOCK, axis=2)
        z = jnp.einsum('bhqd,bhkd->bhqk', qc, k).astype(jnp.float32) * scale
        q_pos = q0 + jnp.arange(Q_BLOCK)
        past = k_pos[None, :] < q_pos[:, None]
        log_one_minus = jnp.where(past, jax.nn.log_sigmoid(-z), 0.0)
        after = lax.cumsum(log_one_minus, axis=3, reverse=True) - log_one_minus
        w = jnp.where(past, jnp.exp(jax.nn.log_sigmoid(z) + after), 0.0)
        return jnp.einsum('bhqk,bhkd->bhqd', w.astype(v.dtype), v)

    out = lax.map(block, jnp.arange(s // Q_BLOCK))
    return out.transpose(1, 2, 0, 3, 4).reshape(b, nh, s, dh)


def moba_attention(q, k, v, rel_bias):
    b, nh, s, dh = q.shape
    scale = dh ** -0.5
    n_blk = -(-s // MOBA_BLOCK)
    s_pad = n_blk * MOBA_BLOCK
    pad = ((0, 0), (0, 0), (0, s_pad - s), (0, 0))
    kb = jnp.pad(k, pad).reshape(b, nh, n_blk, MOBA_BLOCK, dh)
    vb = jnp.pad(v, pad).reshape(b, nh, n_blk, MOBA_BLOCK, dh)
    k_mean = jnp.mean(kb, axis=3)
    n_sel = min(MOBA_TOPK, n_blk - 1)
    bias_hb = rel_bias.T
    in_blk = jnp.arange(MOBA_BLOCK)
    bi = jnp.arange(b)[:, None, None, None]
    hi = jnp.arange(nh)[None, :, None, None]

    def block(c):
        q0 = c * Q_BLOCK
        own = q0 // MOBA_BLOCK
        qc = lax.dynamic_slice_in_dim(q, q0, Q_BLOCK, axis=2)
        q_pos = q0 + jnp.arange(Q_BLOCK)
        k_own = lax.dynamic_index_in_dim(kb, own, axis=2, keepdims=False)
        v_own = lax.dynamic_index_in_dim(vb, own, axis=2, keepdims=False)
        dist_own = q_pos[:, None] - (own * MOBA_BLOCK + in_blk)[None, :]
        logit_own = (jnp.einsum('bhqd,bhkd->bhqk', qc, k_own).astype(jnp.float32) * scale
                     + bias_hb[:, t5_bucket(dist_own)])
        logit_own = jnp.where(dist_own >= 0, logit_own, NEG_BIG)
        if n_sel == 0:
            p_own = jax.nn.softmax(logit_own, axis=-1).astype(v.dtype)
            return jnp.einsum('bhqk,bhkd->bhqd', p_own, v_own)
        gate = jnp.einsum('bhqd,bhnd->bhqn', qc, k_mean).astype(jnp.float32)
        gate = jnp.where(jnp.arange(n_blk) < own, gate, NEG_BIG)
        _, idx = lax.top_k(gate, n_sel)
        valid = idx < own
        k_sel = kb[bi, hi, idx]
        v_sel = vb[bi, hi, idx]
        dist_sel = q_pos[:, None, None] - (idx[..., None] * MOBA_BLOCK + in_blk)
        logit_sel = (jnp.einsum('bhqd,bhqnkd->bhqnk', qc, k_sel).astype(jnp.float32) * scale
                     + bias_hb[hi[..., None], t5_bucket(dist_sel)])
        logit_sel = jnp.where(valid[..., None], logit_sel, NEG_BIG)
        n_s = n_sel * MOBA_BLOCK
        logits = jnp.concatenate([logit_sel.reshape(b, nh, Q_BLOCK, n_s), logit_own], axis=-1)
        p = jax.nn.softmax(logits, axis=-1).astype(v.dtype)
        p_sel = p[..., :n_s].reshape(b, nh, Q_BLOCK, n_sel, MOBA_BLOCK)
        p_own = p[..., n_s:]
        return (jnp.einsum('bhqnk,bhqnkd->bhqd', p_sel, v_sel)
                + jnp.einsum('bhqk,bhkd->bhqd', p_own, v_own))

    out = lax.map(block, jnp.arange(s // Q_BLOCK))
    return out.transpose(1, 2, 0, 3, 4).reshape(b, nh, s, dh)


def swiglu(h, w1, w3, w2):
    hid = jax.nn.silu(jnp.einsum('bsd,df->bsf', h, w1)) * jnp.einsum('bsd,df->bsf', h, w3)
    return jnp.einsum('bsf,fd->bsd', hid, w2)


def moe_swiglu(h, w_router, w1, w3, w2):
    b, s, d = h.shape
    t = h.reshape(b * s, d)
    logits = jnp.dot(t, w_router).astype(jnp.float32)
    top_val, top_idx = lax.top_k(logits, TOP_K)
    top_w = jax.nn.softmax(top_val, axis=-1)
    gates = jnp.einsum('tk,tke->te', top_w,
                       jax.nn.one_hot(top_idx, N_EXPERTS, dtype=jnp.float32)).astype(h.dtype)

    def expert(args):
        e_w1, e_w3, e_w2, g = args
        hid = jax.nn.silu(t @ e_w1) * (t @ e_w3)
        return (hid @ e_w2) * g[:, None]

    y = jnp.sum(lax.map(expert, (w1, w3, w2, gates.T)), axis=0)
    return y.reshape(b, s, d)


def setup_inputs(seed: int = 0) -> dict:
    key = jax.random.key(seed)
    ks = jax.random.split(key, 14)
    nrm = lambda k, shape, fan_in: jax.random.normal(k, shape, jnp.float32) * fan_in ** -0.5
    x = jax.random.normal(ks[0], (BATCH, SEQ, D_MODEL), jnp.float32)
    w_qkv = nrm(ks[1], (DEPTH, D_MODEL, 3 * D_MODEL), D_MODEL)
    w_o = nrm(ks[2], (DEPTH, D_MODEL, D_MODEL), D_MODEL)
    mixer_norm = 1.0 + 0.02 * jax.random.normal(ks[3], (DEPTH, D_MODEL), jnp.float32)
    ffn_norm = 1.0 + 0.02 * jax.random.normal(ks[4], (DEPTH, D_MODEL), jnp.float32)
    rel_bias = 0.5 * jax.random.normal(ks[5], (N_BUCKETS, N_HEADS), jnp.float32)
    w1 = nrm(ks[6], (N_DENSE, D_MODEL, D_FF), D_MODEL)
    w3 = nrm(ks[7], (N_DENSE, D_MODEL, D_FF), D_MODEL)
    w2 = nrm(ks[8], (N_DENSE, D_FF, D_MODEL), D_FF)
    router = nrm(ks[9], (N_MOE, D_MODEL, N_EXPERTS), D_MODEL)
    e_w1 = nrm(ks[10], (N_MOE, N_EXPERTS, D_MODEL, D_FF_EXPERT), D_MODEL)
    e_w3 = nrm(ks[11], (N_MOE, N_EXPERTS, D_MODEL, D_FF_EXPERT), D_MODEL)
    e_w2 = nrm(ks[12], (N_MOE, N_EXPERTS, D_FF_EXPERT, D_MODEL), D_FF_EXPERT)
    final_norm = 1.0 + 0.02 * jax.random.normal(ks[13], (D_MODEL,), jnp.float32)
    return {'x': x, 'w_qkv': w_qkv, 'w_o': w_o, 'mixer_norm': mixer_norm,
            'ffn_norm': ffn_norm, 'rel_bias': rel_bias, 'w1': w1, 'w3': w3, 'w2': w2,
            'router': router, 'e_w1': e_w1, 'e_w3': e_w3, 'e_w2': e_w2,
            'final_norm': final_norm}


def reference(x, w_qkv, w_o, mixer_norm, ffn_norm, rel_bias, w1, w3, w2,
              router, e_w1, e_w3, e_w2, final_norm):
    b, s, d = x.shape
    h = x
    for i in range(DEPTH):
        hn = rmsnorm(h, mixer_norm[i])
        q, k, v = qkv_heads(hn, w_qkv[i])
        if i % 2 == 0:
            o = stick_breaking_attention(q, k, v)
        else:
            o = moba_attention(q, k, v, rel_bias)
        o = o.transpose(0, 2, 1, 3).reshape(b, s, d)
        h = h + jnp.einsum('bsd,de->bse', o, w_o[i])
        hn = rmsnorm(h, ffn_norm[i])
        j = i // 2
        if i % 2 == 0:
            h = h + swiglu(hn, w1[j], w3[j], w2[j])
        else:
            h = h + moe_swiglu(hn, router[j], e_w1[j], e_w3[j], e_w2[j])
    return rmsnorm(h, final_norm)
```

```cpp
#include <hip/hip_runtime.h>
#include <cstdio>
#include <cstdint>

#define GAS __attribute__((address_space(1)))
#define LAS __attribute__((address_space(3)))
typedef unsigned short bf16_t;
typedef short bf16x8 __attribute__((ext_vector_type(8)));
typedef short s16x4 __attribute__((ext_vector_type(4)));
typedef short v4i16_t __attribute__((ext_vector_type(4)));
typedef float f32x4 __attribute__((ext_vector_type(4)));
typedef float f32x16 __attribute__((ext_vector_type(16)));
typedef unsigned u32x4 __attribute__((ext_vector_type(4)));
typedef unsigned u32x2 __attribute__((ext_vector_type(2)));
typedef float f32x2_t __attribute__((ext_vector_type(2)));
typedef __bf16 bf16x2_t __attribute__((ext_vector_type(2)));
typedef GAS unsigned gu32;

constexpr int NB = 8, SEQ = 2048, DM = 1024, NH = 16, HD = 64, M = NB * SEQ;
constexpr int FF = 2816, NE = 8, FE = 3584, NQKV = 3 * DM;
constexpr int MAXT = 135, MAXSLOT = MAXT * 256;
constexpr float RMS_EPS = 1e-6f;
constexpr float LOG2E = 1.4426950408889634f;
constexpr float C2 = 0.125f * LOG2E;
constexpr int NWAVES = 8;

__device__ __forceinline__ unsigned cvtpk(float lo, float hi) { f32x2_t v = {lo, hi}; bf16x2_t b = __builtin_convertvector(v, bf16x2_t); return __builtin_bit_cast(unsigned, b); }
__device__ __forceinline__ float bf2f(unsigned short x) { return __uint_as_float((unsigned)x << 16); }
__device__ __forceinline__ float wave_sum(float v) {
#pragma unroll
    for (int o = 1; o < 64; o <<= 1) v += __shfl_xor(v, o);
    return v;
}

namespace pg8 {
constexpr int BM = 256, BK = 64, HALF = 128, HTB = HALF * BK * 2, STAGE_BYTES = 8 * HTB, NXCD = 8, WGM = 8;
__host__ __device__ __forceinline__ int lds_byte(int r, int c) { const int st = (r >> 4) * 2 + (c >> 5), rr = r & 15, cc = c & 31, ob = rr * 64 + cc * 2; return st * 1024 + (ob ^ (((ob >> 9) & 1) << 5)); }
__host__ __device__ __forceinline__ void stage_rc(int b, int& R, int& C) { const int st = b / 1024, sb = b % 1024, swz = sb ^ (((sb >> 9) & 1) << 5); R = (st >> 1) * 16 + swz / 64; C = (st & 1) * 32 + (swz % 64) / 2; }
__host__ __device__ __forceinline__ int perm32(int rho) { const int n = rho >> 4, i = rho & 15; return 8 * (i >> 2) + 4 * n + (i & 3); }

struct Unit { int pm, pn; };
struct Gemm { const bf16_t* A; const bf16_t* Bt; int M, N, K; const int* rowidx; const int* tile_e; size_t estride; };

struct StaticOrder {
    int nM, nN, nwg, G, c;
    __host__ __device__ void init(int M_, int N_, int G_, int c_) { nM = M_ / BM; nN = N_ / BM; nwg = nM * nN; G = G_; c = c_; }
    __host__ __device__ bool next(int i, Unit& u) const {
        const long L = (long)i * G + c; if (L >= nwg) return false;
        int wgid = (int)L; { const int q = nwg / NXCD, r = nwg % NXCD, xcd = wgid % NXCD, off = wgid / NXCD; wgid = (xcd < r ? xcd * (q + 1) : r * (q + 1) + (xcd - r) * q) + off; }
        const int nig = WGM * nN, gid = wgid / nig, fm = gid * WGM, gsz = (nM - fm) < WGM ? (nM - fm) : WGM;
        u.pm = fm + ((wgid % nig) % gsz); u.pn = (wgid % nig) / gsz; return true;
    }
};

template <int NP> struct RowScale {
    const float* p;
    __device__ __forceinline__ float get(int row) const {
        if constexpr (NP == 16) { const f32x4* q = (const f32x4*)(p + (size_t)row * 16); const f32x4 a = q[0], b = q[1], c = q[2], d = q[3];
            const float s = ((a[0] + a[1]) + (a[2] + a[3])) + ((b[0] + b[1]) + (b[2] + b[3])) + ((c[0] + c[1]) + (c[2] + c[3])) + ((d[0] + d[1]) + (d[2] + d[3]));
            return __builtin_amdgcn_rsqf(s * (1.0f / DM) + RMS_EPS); }
        else return p[row];
    }
};

template <int NP> struct EpiBf16 {
    static constexpr bool PERM = true;
    bf16_t* O; int ldc; int split_cols; size_t split_stride; float scale0; const float* rs;
    __device__ __forceinline__ void operator()(const f32x4 (&acc)[2][2][4][2], const Unit& u, int wr, int wc, int fr, int fq) const {
        const int row0 = u.pm * BM + wr * 64 + fr; int colt = u.pn * BM; bf16_t* base = O;
        float sc = 1.f; if (split_cols) { const int t = colt / split_cols; base += (size_t)t * split_stride; colt -= t * split_cols; if (t == 0) sc = scale0; }
        const int col0 = colt + wc * 32 + 8 * fq;
        const RowScale<NP> R{rs};
#pragma unroll
        for (int ai = 0; ai < 2; ++ai)
#pragma unroll
            for (int m = 0; m < 4; ++m) { const int row = row0 + ai * HALF + m * 16; bf16_t* rowp = base + (size_t)row * ldc + col0;
                const float s = rs ? R.get(row) * sc : sc;
#pragma unroll
                for (int bj = 0; bj < 2; ++bj) { const f32x4 v0 = acc[ai][bj][m][0] * s, v1 = acc[ai][bj][m][1] * s;
                    u32x4 w; w.x = cvtpk(v0[0], v0[1]); w.y = cvtpk(v0[2], v0[3]); w.z = cvtpk(v1[0], v1[1]); w.w = cvtpk(v1[2], v1[3]);
                    *(u32x4*)(rowp + bj * HALF) = w; } }
    }
};
template <int NP> struct EpiSwiglu {
    static constexpr bool PERM = true;
    bf16_t* O; int ldc; const float* rs;
    __device__ __forceinline__ void operator()(const f32x4 (&acc)[2][2][4][2], const Unit& u, int wr, int wc, int fr, int fq) const {
        const int row0 = u.pm * BM + wr * 64 + fr; const int col0 = u.pn * HALF + wc * 32 + 8 * fq;
        const RowScale<NP> R{rs};
#pragma unroll
        for (int ai = 0; ai < 2; ++ai)
#pragma unroll
            for (int m = 0; m < 4; ++m) { const int row = row0 + ai * HALF + m * 16; const float r = R.get(row);
                float hv[8];
#pragma unroll
                for (int n = 0; n < 2; ++n)
#pragma unroll
                    for (int e = 0; e < 4; ++e) { const float g = acc[ai][0][m][n][e] * r, uu = acc[ai][1][m][n][e] * r;
                        const float sg = __builtin_amdgcn_rcpf(1.0f + __builtin_amdgcn_exp2f(-g * LOG2E));
                        hv[n * 4 + e] = g * sg * uu; }
                u32x4 w; w.x = cvtpk(hv[0], hv[1]); w.y = cvtpk(hv[2], hv[3]); w.z = cvtpk(hv[4], hv[5]); w.w = cvtpk(hv[6], hv[7]);
                *(u32x4*)(O + (size_t)row * ldc + col0) = w; }
    }
};
struct EpiRes {
    static constexpr bool PERM = true;
    const float* base; float* out; bf16_t* hb; float* ssp;
    __device__ __forceinline__ void operator()(const f32x4 (&acc)[2][2][4][2], const Unit& u, int wr, int wc, int fr, int fq) const {
        const int row0 = u.pm * BM + wr * 64 + fr; const int col0 = u.pn * BM + wc * 32 + 8 * fq;
#pragma unroll
        for (int ai = 0; ai < 2; ++ai)
#pragma unroll
            for (int m = 0; m < 4; ++m) { const int row = row0 + ai * HALF + m * 16; const size_t off = (size_t)row * DM + col0; float ss = 0.f;
#pragma unroll
                for (int bj = 0; bj < 2; ++bj) { const f32x4 b0 = *(const f32x4*)(base + off + bj * HALF), b1 = *(const f32x4*)(base + off + bj * HALF + 4);
                    const f32x4 v0 = acc[ai][bj][m][0] + b0, v1 = acc[ai][bj][m][1] + b1;
                    *(f32x4*)(out + off + bj * HALF) = v0; *(f32x4*)(out + off + bj * HALF + 4) = v1;
                    u32x4 w; w.x = cvtpk(v0[0], v0[1]); w.y = cvtpk(v0[2], v0[3]); w.z = cvtpk(v1[0], v1[1]); w.w = cvtpk(v1[2], v1[3]);
                    *(u32x4*)(hb + off + bj * HALF) = w;
                    ss += ((v0[0] * v0[0] + v0[1] * v0[1]) + (v0[2] * v0[2] + v0[3] * v0[3])) + ((v1[0] * v1[0] + v1[1] * v1[1]) + (v1[2] * v1[2] + v1[3] * v1[3])); }
                ss += __shfl_xor(ss, 16); ss += __shfl_xor(ss, 32);
                if (fq == 0) ssp[(size_t)row * 16 + u.pn * 4 + wc] = ss; }
    }
};

template <class Epi, bool GATHER, bool EXPB>
__device__ __forceinline__ void gemm_phase(LAS unsigned char* lds, const Gemm g, const StaticOrder& S, const Epi& E) {
    int tid = threadIdx.x; asm volatile("" : "+v"(tid));
    const int wid = __builtin_amdgcn_readfirstlane(tid >> 6), lane = tid & 63, wr = wid >> 2, wc = wid & 3, fr = lane & 15, fq = lane >> 4;
    const int K = g.K, nt = K / BK;
    const size_t kstep = (size_t)(BK * 2);
    const size_t hstep = (size_t)HALF * K * 2;
    const size_t tstep = 2 * hstep;
    int Rr[2], Cc[2]; unsigned voffB[2];
    unsigned vA[2][2], vN[2][2];
#pragma unroll
    for (int i = 0; i < 2; ++i) { int R, C; stage_rc(tid * 16 + i * 8192, R, C); Rr[i] = R; Cc[i] = C; const int Rb = Epi::PERM ? ((R & ~31) + perm32(R & 31)) : R;
        voffB[i] = (unsigned)(Rb * K + C) * 2u;
        vA[0][i] = (unsigned)(R * K + C) * 2u; vA[1][i] = vA[0][i] + (unsigned)hstep; vN[0][i] = vA[0][i]; vN[1][i] = vA[1][i]; }
    const unsigned ldsw = (unsigned)wid * 1024u;
    const int aoff = lds_byte(wr * 64 + fr, fq * 8), boff = lds_byte(wc * 32 + fr, fq * 8);
#define PG8_SA(b, h) (((b) * 2 + (h)) * HTB)
#define PG8_SB(b, h) ((4 + (b) * 2 + (h)) * HTB)
#define PG8_STAGE(bufoff, gbase, voff) do { _Pragma("unroll") for (int _i = 0; _i < 2; ++_i) \
        __builtin_amdgcn_global_load_lds((const unsigned*)((const char*)(gbase) + (voff)[_i]), (LAS unsigned*)(lds + (bufoff) + ldsw + _i * 8192), 16, 0, 0); } while (0)
#define PG8_LDA(dst, b, h) do { _Pragma("unroll") for (int m = 0; m < 4; ++m) _Pragma("unroll") for (int k = 0; k < 2; ++k) dst[m][k] = *(const LAS bf16x8*)(lds + PG8_SA(b, h) + aoff + m * 2048 + k * 1024); } while (0)
#define PG8_LDB(dst, b, h) do { _Pragma("unroll") for (int n = 0; n < 2; ++n) _Pragma("unroll") for (int k = 0; k < 2; ++k) dst[n][k] = *(const LAS bf16x8*)(lds + PG8_SB(b, h) + boff + n * 2048 + k * 1024); } while (0)
#define PG8_MMA(ai, bj, At, Bt) do { __builtin_amdgcn_s_setprio(1); _Pragma("unroll") for (int m = 0; m < 4; ++m) _Pragma("unroll") for (int n = 0; n < 2; ++n) _Pragma("unroll") for (int k = 0; k < 2; ++k) \
        acc[ai][bj][m][n] = __builtin_amdgcn_mfma_f32_16x16x32_bf16(Bt[n][k], At[m][k], acc[ai][bj][m][n], 0, 0, 0); __builtin_amdgcn_s_setprio(0); } while (0)
#define PG8_WAIT_V(n) asm volatile("s_waitcnt vmcnt(" #n ")" ::: "memory")
#define PG8_WAIT_L(n) asm volatile("s_waitcnt lgkmcnt(" #n ")" ::: "memory")
#define PG8_BAR __builtin_amdgcn_s_barrier()
#define PG8_SCHED __builtin_amdgcn_sched_barrier(0)
#define PG8_APTR(u) (GATHER ? (const char*)g.A : (const char*)g.A + (size_t)(u).pm * tstep)
#define PG8_BPTR(u) ((const char*)g.Bt + (EXPB ? (size_t)__builtin_amdgcn_readfirstlane(__hip_atomic_load(g.tile_e + (u).pm, __ATOMIC_RELAXED, __HIP_MEMORY_SCOPE_AGENT)) * g.estride * 2 : (size_t)0) + (size_t)(u).pn * tstep)
#define PG8_GOFF(dst, u) do { _Pragma("unroll") for (int _h = 0; _h < 2; ++_h) _Pragma("unroll") for (int _i = 0; _i < 2; ++_i) \
        dst[_h][_i] = (unsigned)g.rowidx[(u).pm * BM + _h * HALF + Rr[_i]] * (unsigned)(K * 2) + (unsigned)(Cc[_i] * 2); } while (0)
    Unit cur, nxt; int ui = 0;
    if (!S.next(0, cur)) return;
    f32x4 acc[2][2][4][2];
#pragma unroll
    for (int a = 0; a < 2; ++a)
#pragma unroll
        for (int b = 0; b < 2; ++b)
#pragma unroll
            for (int m = 0; m < 4; ++m)
#pragma unroll
                for (int n = 0; n < 2; ++n) acc[a][b][m][n] = (f32x4){0.f, 0.f, 0.f, 0.f};
    bf16x8 At[4][2], B0[2][2], B1[2][2];
    const char* cA = PG8_APTR(cur); const char* cB = PG8_BPTR(cur);
    if constexpr (GATHER) { PG8_GOFF(vA, cur); }
    PG8_STAGE(PG8_SB(0, 0), cB, voffB); PG8_STAGE(PG8_SB(0, 1), cB + hstep, voffB); PG8_STAGE(PG8_SA(0, 0), cA, vA[0]); PG8_STAGE(PG8_SA(0, 1), cA, vA[1]);
    if (wr == 1) PG8_BAR;
    PG8_WAIT_V(2); PG8_BAR;
    PG8_STAGE(PG8_SB(1, 0), cB + kstep, voffB); PG8_STAGE(PG8_SA(1, 0), cA + kstep, vA[0]); PG8_STAGE(PG8_SB(1, 1), cB + hstep + kstep, voffB);
    PG8_WAIT_V(6); PG8_BAR;
    for (;;) {
        const bool has_next = S.next(ui + 1, nxt);
        const char* nA = has_next ? PG8_APTR(nxt) : cA; const char* nB = has_next ? PG8_BPTR(nxt) : cB;
        if constexpr (GATHER) { if (has_next) { PG8_GOFF(vN, nxt); } else {
#pragma unroll
            for (int h = 0; h < 2; ++h)
#pragma unroll
                for (int i = 0; i < 2; ++i) vN[h][i] = vA[h][i]; } }
        for (int t = 0; t < nt; t += 2) {
            const bool last = (t == nt - 2);
            const char* a1 = cA + (size_t)(t + 1) * kstep;
            const char* a2 = last ? nA : cA + (size_t)(t + 2) * kstep; const char* b2 = last ? nB : cB + (size_t)(t + 2) * kstep;
            const char* a3 = a2 + kstep; const char* b3 = b2 + kstep;
            unsigned v2[2][2];
#pragma unroll
            for (int h = 0; h < 2; ++h)
#pragma unroll
                for (int i = 0; i < 2; ++i) v2[h][i] = (GATHER && last) ? vN[h][i] : vA[h][i];
            PG8_LDB(B0, 0, 0); PG8_LDB(B1, 0, 1); PG8_SCHED; PG8_LDA(At, 0, 0); PG8_STAGE(PG8_SA(1, 1), a1, vA[1]);
            PG8_WAIT_V(8); PG8_WAIT_L(0); PG8_BAR; PG8_MMA(0, 0, At, B0); PG8_MMA(0, 1, At, B1); PG8_BAR; PG8_SCHED;
            PG8_LDA(At, 0, 1); PG8_STAGE(PG8_SB(0, 0), b2, voffB); PG8_STAGE(PG8_SB(0, 1), b2 + hstep, voffB); PG8_STAGE(PG8_SA(0, 0), a2, v2[0]);
            PG8_WAIT_V(8); PG8_WAIT_L(0); PG8_BAR; PG8_MMA(1, 0, At, B0); PG8_MMA(1, 1, At, B1); PG8_BAR; PG8_SCHED;
            PG8_LDB(B0, 1, 0); PG8_LDB(B1, 1, 1); PG8_SCHED; PG8_LDA(At, 1, 0); PG8_STAGE(PG8_SA(0, 1), a2, v2[1]);
            PG8_WAIT_V(8); PG8_WAIT_L(0); PG8_BAR; PG8_MMA(0, 0, At, B0); PG8_MMA(0, 1, At, B1); PG8_BAR; PG8_SCHED;
            PG8_LDA(At, 1, 1); PG8_STAGE(PG8_SB(1, 0), b3, voffB); PG8_STAGE(PG8_SB(1, 1), b3 + hstep, voffB); PG8_STAGE(PG8_SA(1, 0), a3, v2[0]);
            PG8_WAIT_V(8); PG8_WAIT_L(0); PG8_BAR; PG8_MMA(1, 0, At, B0); PG8_MMA(1, 1, At, B1); PG8_BAR; PG8_SCHED;
        }
        if (wr == 0) PG8_BAR;
        E(acc, cur, wr, wc, fr, fq);
        if (!has_next) break;
#pragma unroll
        for (int a = 0; a < 2; ++a)
#pragma unroll
            for (int b = 0; b < 2; ++b)
#pragma unroll
                for (int m = 0; m < 4; ++m)
#pragma unroll
                    for (int n = 0; n < 2; ++n) acc[a][b][m][n] = (f32x4){0.f, 0.f, 0.f, 0.f};
        cur = nxt; cA = nA; cB = nB; ++ui;
#pragma unroll
        for (int h = 0; h < 2; ++h)
#pragma unroll
            for (int i = 0; i < 2; ++i) vA[h][i] = vN[h][i];
        if (wr == 1) PG8_BAR;
    }
    PG8_WAIT_V(0);
    PG8_BAR;
#undef PG8_SA
#undef PG8_SB
#undef PG8_STAGE
#undef PG8_LDA
#undef PG8_LDB
#undef PG8_MMA
#undef PG8_WAIT_V
#undef PG8_WAIT_L
#undef PG8_BAR
#undef PG8_SCHED
#undef PG8_APTR
#undef PG8_BPTR
#undef PG8_GOFF
}
}

namespace att {
constexpr int SLOTB = 8192;
constexpr int L_K = 0, L_V = 2 * SLOTB, L_WS = 4 * SLOTB, L_OST = L_WS + NWAVES * 256, L_TAB = L_OST + NWAVES * 4096, L_FLAG = L_TAB + 4096, L_BYTES = L_FLAG + 256;
#define SBAR() __builtin_amdgcn_sched_barrier(0)
#define WAIT_BAR0() asm volatile("s_waitcnt vmcnt(0) lgkmcnt(0)\n\ts_barrier" ::: "memory")
__device__ __forceinline__ int crow(int r, int hi) { return (r & 3) + 8 * (r >> 2) + 4 * hi; }
__device__ __forceinline__ void glds16(const void* gsrc, unsigned lds_dst) { unsigned keep;
    asm volatile("s_mov_b32 %0, m0\n\ts_mov_b32 m0, %2\n\ts_nop 0\n\tglobal_load_lds_dwordx4 %1, off\n\ts_mov_b32 m0, %0" : "=&s"(keep) : "v"(gsrc), "s"(lds_dst) : "memory"); }
__device__ __forceinline__ void qkt(f32x16& p0, f32x16& p1, const LAS char* Kslot, const bf16x8* qr, const f32x16& c0, int r32, int hi) {
    const LAS char* kb = Kslot + hi * 1024 + r32 * 16;
#pragma unroll
    for (int d0 = 0; d0 < 4; ++d0) {
        const bf16x8 b0 = *(const LAS bf16x8*)(kb + d0 * 2048);
        const bf16x8 b1 = *(const LAS bf16x8*)(kb + d0 * 2048 + 512);
        if (d0 == 0) { p0 = __builtin_amdgcn_mfma_f32_32x32x16_bf16(b0, qr[0], c0, 0, 0, 0); p1 = __builtin_amdgcn_mfma_f32_32x32x16_bf16(b1, qr[0], c0, 0, 0, 0); }
        else { p0 = __builtin_amdgcn_mfma_f32_32x32x16_bf16(b0, qr[d0], p0, 0, 0, 0); p1 = __builtin_amdgcn_mfma_f32_32x32x16_bf16(b1, qr[d0], p1, 0, 0, 0); } }
}
__device__ __forceinline__ void pv(f32x16* o, int vb, bf16x8 pa0, bf16x8 pa1, bf16x8 pa2, bf16x8 pa3) {
#pragma unroll
    for (int d0 = 0; d0 < 2; ++d0) { s16x4 lo[4], hi[4];
#pragma unroll
        for (int ks = 0; ks < 4; ++ks) {
            asm volatile("ds_read_b64_tr_b16 %0,%1 offset:%c2" : "=&v"(lo[ks]) : "v"(vb), "i"(d0 * 4096 + ks * 1024) : "memory");
            asm volatile("ds_read_b64_tr_b16 %0,%1 offset:%c2" : "=&v"(hi[ks]) : "v"(vb), "i"(d0 * 4096 + ks * 1024 + 512) : "memory"); }
        asm volatile("s_waitcnt lgkmcnt(0)" ::: "memory"); SBAR();
#define PK(k) (bf16x8){lo[k][0], lo[k][1], lo[k][2], lo[k][3], hi[k][0], hi[k][1], hi[k][2], hi[k][3]}
        o[d0] = __builtin_amdgcn_mfma_f32_32x32x16_bf16(pa0, PK(0), o[d0], 0, 0, 0);
        o[d0] = __builtin_amdgcn_mfma_f32_32x32x16_bf16(pa1, PK(1), o[d0], 0, 0, 0);
        o[d0] = __builtin_amdgcn_mfma_f32_32x32x16_bf16(pa2, PK(2), o[d0], 0, 0, 0);
        o[d0] = __builtin_amdgcn_mfma_f32_32x32x16_bf16(pa3, PK(3), o[d0], 0, 0, 0);
#undef PK
    }
}
__device__ __forceinline__ float swap_sum(float v) { auto rr = __builtin_amdgcn_permlane32_swap(__float_as_uint(v), __float_as_uint(v), false, false); return __uint_as_float(rr[0]) + __uint_as_float(rr[1]); }
__device__ __forceinline__ float swap_max(float v) { auto rr = __builtin_amdgcn_permlane32_swap(__float_as_uint(v), __float_as_uint(v), false, false); return __builtin_fmaxf(__uint_as_float(rr[0]), __uint_as_float(rr[1])); }
__device__ __forceinline__ float swap_other(float v, int hi) { auto rr = __builtin_amdgcn_permlane32_swap(__float_as_uint(v), __float_as_uint(v), false, false); return __uint_as_float(hi ? rr[0] : rr[1]); }

#define PKW(P, B) cvtpk(P[B], P[B + 1])
__device__ __forceinline__ void store_o(const f32x16* o, const float* rli, bf16_t* Ow, LAS char* shm, int wid, int lane, int r32, int hi) {
    LAS bf16_t* stg = (LAS bf16_t*)(shm + L_OST) + wid * 2048;
#pragma unroll
    for (int r = 0; r < 16; ++r) { const int orow = crow(r, hi);
#pragma unroll
        for (int d0 = 0; d0 < 2; ++d0) stg[orow * 64 + d0 * 32 + r32] = (bf16_t)(cvtpk(o[d0][r] * rli[r], 0.f) & 0xffffu); }
    asm volatile("s_waitcnt lgkmcnt(0)" ::: "memory");
#pragma unroll
    for (int i = 0; i < 4; ++i) { const int row = i * 8 + (lane >> 3), ch = lane & 7; const u32x4 v = *(const LAS u32x4*)(stg + row * 64 + ch * 8); *(u32x4*)(Ow + (size_t)row * DM + ch * 8) = v; }
}

__device__ __forceinline__ void sb_half(f32x16& P, float carry_in, float& total, int hi, int t, int s_base) {
    float L[16], lw[16];
#pragma unroll
    for (int r = 0; r < 16; ++r) { const float z = P[r]; const float az = __builtin_fabsf(z);
        const float sp = __builtin_fmaxf(z, 0.f) + __builtin_amdgcn_logf(1.0f + __builtin_amdgcn_exp2f(-az));
        const bool valid = (s_base + crow(r, hi)) < t;
        L[r] = valid ? -sp : 0.f; lw[r] = valid ? (z - sp) : -INFINITY; }
    float G[4], T[4], Gp[4];
#pragma unroll
    for (int g = 0; g < 4; ++g) { G[g] = (L[4 * g] + L[4 * g + 1]) + (L[4 * g + 2] + L[4 * g + 3]);
        auto rr = __builtin_amdgcn_permlane32_swap(__float_as_uint(G[g]), __float_as_uint(G[g]), false, false);
        T[g] = __uint_as_float(rr[0]) + __uint_as_float(rr[1]); Gp[g] = __uint_as_float(hi ? rr[0] : rr[1]); }
    float st = carry_in;
#pragma unroll
    for (int g = 3; g >= 0; --g) {
        float a = st + (hi ? 0.f : Gp[g]);
        P[4 * g + 3] = __builtin_amdgcn_exp2f(lw[4 * g + 3] + a); a += L[4 * g + 3];
        P[4 * g + 2] = __builtin_amdgcn_exp2f(lw[4 * g + 2] + a); a += L[4 * g + 2];
        P[4 * g + 1] = __builtin_amdgcn_exp2f(lw[4 * g + 1] + a); a += L[4 * g + 1];
        P[4 * g + 0] = __builtin_amdgcn_exp2f(lw[4 * g + 0] + a);
        st += T[g]; }
    total = (T[0] + T[1]) + (T[2] + T[3]);
}
__device__ __forceinline__ void sb_unit(int b, int h, int qb, const bf16_t* Q, const bf16_t* K, const bf16_t* V, bf16_t* O, LAS char* shm) {
    int tid = threadIdx.x; asm volatile("" : "+v"(tid));
    const int lane = tid & 63, r32 = lane & 31, hi = lane >> 5; const int wid = __builtin_amdgcn_readfirstlane(tid >> 6);
    const size_t rowbase = (size_t)b * SEQ; const int q0 = qb * 256;
    const bf16_t* Qw = Q + (rowbase + q0 + wid * 32) * DM + h * HD;
    const bf16_t* Kh = K + rowbase * DM + h * HD; const bf16_t* Vh = V + rowbase * DM + h * HD;
    const unsigned lds0 = (unsigned)(uintptr_t)shm;
    const bf16_t* ksrc = Kh + (size_t)lane * DM + wid * 8;
    const bf16_t* vsrc = Vh + (size_t)(16 * (wid & 3) + (lane >> 2)) * DM + (wid >> 2) * 32 + (lane & 3) * 8;
    const unsigned kdst = lds0 + L_K + wid * 1024, vdst = lds0 + L_V + wid * 1024;
    const int vb0 = (int)(lds0 + L_V) + ((lane >> 4) & 1) * 32 + (lane & 3) * 8 + (4 * hi + ((lane & 15) >> 2)) * 64;
    LAS int* flags = (LAS int*)(shm + L_FLAG);
    bf16x8 qr[4];
#pragma unroll
    for (int d0 = 0; d0 < 4; ++d0) qr[d0] = *(const bf16x8*)(Qw + (size_t)r32 * DM + d0 * 16 + hi * 8);
    const int t = q0 + wid * 32 + r32;
    const int jtw = (q0 + wid * 32) >> 6;
    f32x16 o[2]; o[0] = f32x16{}; o[1] = f32x16{};
    float carry = 0.f; bool mydone = false;
    int cur = 4 * qb + 3, slot = 0, it = 0;
    glds16(ksrc + (size_t)cur * 64 * DM, (unsigned)__builtin_amdgcn_readfirstlane(kdst));
    glds16(vsrc + (size_t)cur * 64 * DM, (unsigned)__builtin_amdgcn_readfirstlane(vdst));
    for (;;) {
        WAIT_BAR0();
        if (it > 0) {
            int all = 1;
#pragma unroll
            for (int w = 0; w < NWAVES; ++w) all &= flags[((it - 1) & 1) * NWAVES + w];
            if (__builtin_amdgcn_readfirstlane(all)) break;
        }
        if (cur > 0) { glds16(ksrc + (size_t)(cur - 1) * 64 * DM, (unsigned)__builtin_amdgcn_readfirstlane(kdst + (slot ^ 1) * SLOTB));
                       glds16(vsrc + (size_t)(cur - 1) * 64 * DM, (unsigned)__builtin_amdgcn_readfirstlane(vdst + (slot ^ 1) * SLOTB)); }
        if (cur <= jtw && !mydone) {
            f32x16 p0, p1; const f32x16 zero = f32x16{};
            qkt(p0, p1, shm + L_K + slot * SLOTB, qr, zero, r32, hi);
            float tot1, tot0;
            sb_half(p1, carry, tot1, hi, t, 64 * cur + 32);
            sb_half(p0, carry + tot1, tot0, hi, t, 64 * cur);
            carry += tot1 + tot0;
            u32x4 pw0 = (u32x4){PKW(p0, 0), PKW(p0, 2), PKW(p0, 4), PKW(p0, 6)}, pw1 = (u32x4){PKW(p0, 8), PKW(p0, 10), PKW(p0, 12), PKW(p0, 14)};
            u32x4 pw2 = (u32x4){PKW(p1, 0), PKW(p1, 2), PKW(p1, 4), PKW(p1, 6)}, pw3 = (u32x4){PKW(p1, 8), PKW(p1, 10), PKW(p1, 12), PKW(p1, 14)};
            SBAR();
            pv(o, vb0 + slot * SLOTB, __builtin_bit_cast(bf16x8, pw0), __builtin_bit_cast(bf16x8, pw1), __builtin_bit_cast(bf16x8, pw2), __builtin_bit_cast(bf16x8, pw3));
            mydone = __all(carry < -200.0f);
        }
        if (lane == 0) flags[(it & 1) * NWAVES + wid] = mydone ? 1 : 0;
        if (cur == 0) break;
        --cur; slot ^= 1; ++it;
    }
    float one[16];
#pragma unroll
    for (int r = 0; r < 16; ++r) one[r] = 1.0f;
    store_o(o, one, O + (rowbase + q0 + wid * 32) * DM + h * HD, shm, wid, lane, r32, hi);
    WAIT_BAR0();
}

__device__ const unsigned char T5B[128] = {0, 1, 2, 3, 4, 5, 6, 7, 8, 9, 10, 11, 12, 13, 14, 15, 16, 16, 16, 17, 17, 18, 18, 18, 19, 19, 19, 20, 20, 20, 20, 21, 21, 21, 21, 22, 22, 22, 22, 22, 23, 23, 23, 23, 23, 23,
    24, 24, 24, 24, 24, 24, 25, 25, 25, 25, 25, 25, 25, 26, 26, 26, 26, 26, 26, 26, 26, 27, 27, 27, 27, 27, 27, 27, 27, 27, 27, 28, 28, 28, 28, 28, 28, 28, 28, 28, 28, 29, 29, 29, 29, 29, 29, 29, 29, 29, 29, 29, 29,
    30, 30, 30, 30, 30, 30, 30, 30, 30, 30, 30, 30, 30, 30, 31, 31, 31, 31, 31, 31, 31, 31, 31, 31, 31, 31, 31, 31, 31};
__device__ __forceinline__ void moba_unit(int b, int h, int own, const bf16_t* Q, const bf16_t* K, const bf16_t* V, bf16_t* O, const float* km, const float* rel_bias, LAS char* shm) {
    int tid = threadIdx.x; asm volatile("" : "+v"(tid));
    const int lane = tid & 63, r32 = lane & 31, hi = lane >> 5; const int wid = __builtin_amdgcn_readfirstlane(tid >> 6);
    const size_t rowbase = (size_t)b * SEQ; const int q0 = own * 256;
    const bf16_t* Qw = Q + (rowbase + q0 + wid * 32) * DM + h * HD;
    const bf16_t* Kh = K + rowbase * DM + h * HD; const bf16_t* Vh = V + rowbase * DM + h * HD;
    const unsigned lds0 = (unsigned)(uintptr_t)shm;
    const bf16_t* ksrc = Kh + (size_t)lane * DM + wid * 8;
    const bf16_t* vsrc = Vh + (size_t)(16 * (wid & 3) + (lane >> 2)) * DM + (wid >> 2) * 32 + (lane & 3) * 8;
    const unsigned kdst = lds0 + L_K + wid * 1024, vdst = lds0 + L_V + wid * 1024;
    const int vb0 = (int)(lds0 + L_V) + ((lane >> 4) & 1) * 32 + (lane & 3) * 8 + (4 * hi + ((lane & 15) >> 2)) * 64;
    LAS float* wsf = (LAS float*)(shm + L_WS) + wid * 64;
    LAS float* kmL = (LAS float*)(shm + L_TAB);
    LAS float* dlL = kmL + 512;
    kmL[tid] = km[(size_t)(b * NH + h) * 512 + tid];
    if (tid < 128) dlL[tid] = (rel_bias[(int)T5B[tid] * NH + h] - rel_bias[31 * NH + h]) * LOG2E;
    const int NT = 4 * own + 4;
    glds16(ksrc, (unsigned)__builtin_amdgcn_readfirstlane(kdst));
    glds16(vsrc, (unsigned)__builtin_amdgcn_readfirstlane(vdst));
    bf16x8 qr[4];
#pragma unroll
    for (int d0 = 0; d0 < 4; ++d0) qr[d0] = *(const bf16x8*)(Qw + (size_t)r32 * DM + d0 * 16 + hi * 8);
    WAIT_BAR0();
    unsigned sel = 0;
    {
        float gp[8];
#pragma unroll
        for (int n = 0; n < 8; ++n) gp[n] = 0.f;
#pragma unroll
        for (int d0 = 0; d0 < 4; ++d0)
#pragma unroll
            for (int n = 0; n < 8; ++n) { const LAS f32x4* kp = (const LAS f32x4*)(kmL + n * 64 + d0 * 16 + hi * 8); const f32x4 k0 = kp[0], k1 = kp[1];
                gp[n] += bf2f((unsigned short)qr[d0][0]) * k0[0] + bf2f((unsigned short)qr[d0][1]) * k0[1] + bf2f((unsigned short)qr[d0][2]) * k0[2] + bf2f((unsigned short)qr[d0][3]) * k0[3]
                       + bf2f((unsigned short)qr[d0][4]) * k1[0] + bf2f((unsigned short)qr[d0][5]) * k1[1] + bf2f((unsigned short)qr[d0][6]) * k1[2] + bf2f((unsigned short)qr[d0][7]) * k1[3]; }
        float gt[8];
#pragma unroll
        for (int n = 0; n < 8; ++n) gt[n] = swap_sum(gp[n]);
#pragma unroll
        for (int n = 0; n < 8; ++n) { int rank = 0;
#pragma unroll
            for (int m2 = 0; m2 < 8; ++m2) if (m2 != n) rank += (m2 < own && (gt[m2] > gt[n] || (gt[m2] == gt[n] && m2 < n))) ? 1 : 0;
            if (n < own && rank < 3) sel |= 1u << n; }
    }
    const int t = q0 + wid * 32 + r32;
    f32x16 o[2]; o[0] = f32x16{}; o[1] = f32x16{};
    float m_run = -1e30f, l_run = 0.f;
    for (int tt = 0; tt < NT; ++tt) {
        const int slot = tt & 1;
        if (tt > 0) WAIT_BAR0();
        if (tt + 1 < NT) { glds16(ksrc + (size_t)(tt + 1) * 64 * DM, (unsigned)__builtin_amdgcn_readfirstlane(kdst + (slot ^ 1) * SLOTB));
                           glds16(vsrc + (size_t)(tt + 1) * 64 * DM, (unsigned)__builtin_amdgcn_readfirstlane(vdst + (slot ^ 1) * SLOTB)); }
        const int n = tt >> 2; const bool ownb = (n == own); const int key0 = 64 * tt;
        if (ownb && key0 > q0 + wid * 32 + 31) continue;
        const bool lsel = ownb || ((sel >> n) & 1u);
        f32x16 c0; { const float cv = lsel ? 0.f : -INFINITY;
#pragma unroll
            for (int r = 0; r < 16; ++r) c0[r] = cv; }
        f32x16 p0, p1;
        qkt(p0, p1, shm + L_K + slot * SLOTB, qr, c0, r32, hi);
        if (key0 + 63 + 127 >= q0 + wid * 32) {
#pragma unroll
            for (int r = 0; r < 16; ++r) { const int d0 = t - (key0 + crow(r, hi)), d1 = d0 - 32;
                if (d0 < 0) p0[r] = -INFINITY; else if (d0 < 128) p0[r] += dlL[d0];
                if (d1 < 0) p1[r] = -INFINITY; else if (d1 < 128) p1[r] += dlL[d1]; }
        }
        float mx = p0[0];
#pragma unroll
        for (int r = 1; r < 16; ++r) mx = __builtin_fmaxf(mx, p0[r]);
#pragma unroll
        for (int r = 0; r < 16; ++r) mx = __builtin_fmaxf(mx, p1[r]);
        mx = swap_max(mx);
        const float m_new = __builtin_fmaxf(m_run, mx);
        const float alpha = __builtin_amdgcn_exp2f(m_run - m_new);
        m_run = m_new;
        float ls = 0.f;
#pragma unroll
        for (int r = 0; r < 16; ++r) { p0[r] = __builtin_amdgcn_exp2f(p0[r] - m_new); ls += p0[r]; }
#pragma unroll
        for (int r = 0; r < 16; ++r) { p1[r] = __builtin_amdgcn_exp2f(p1[r] - m_new); ls += p1[r]; }
        l_run = l_run * alpha + ls;
        if (__any(alpha != 1.0f)) {
            if (hi == 0) wsf[r32] = alpha;
            asm volatile("s_waitcnt lgkmcnt(0)" ::: "memory");
#pragma unroll
            for (int r = 0; r < 16; ++r) { const float f = wsf[crow(r, hi)]; o[0][r] *= f; o[1][r] *= f; }
        }
        u32x4 pw0 = (u32x4){PKW(p0, 0), PKW(p0, 2), PKW(p0, 4), PKW(p0, 6)}, pw1 = (u32x4){PKW(p0, 8), PKW(p0, 10), PKW(p0, 12), PKW(p0, 14)};
        u32x4 pw2 = (u32x4){PKW(p1, 0), PKW(p1, 2), PKW(p1, 4), PKW(p1, 6)}, pw3 = (u32x4){PKW(p1, 8), PKW(p1, 10), PKW(p1, 12), PKW(p1, 14)};
        SBAR();
        pv(o, vb0 + slot * SLOTB, __builtin_bit_cast(bf16x8, pw0), __builtin_bit_cast(bf16x8, pw1), __builtin_bit_cast(bf16x8, pw2), __builtin_bit_cast(bf16x8, pw3));
    }
    const float lt = swap_sum(l_run);
    if (hi == 0) wsf[32 + r32] = lt;
    asm volatile("s_waitcnt lgkmcnt(0)" ::: "memory");
    float rli[16];
#pragma unroll
    for (int r = 0; r < 16; ++r) rli[r] = __builtin_amdgcn_rcpf(wsf[32 + crow(r, hi)]);
    store_o(o, rli, O + (rowbase + q0 + wid * 32) * DM + h * HD, shm, wid, lane, r32, hi);
    WAIT_BAR0();
}
#undef PKW
#undef SBAR
#undef WAIT_BAR0
}

constexpr size_t MiB = 1u << 20, KiB = 1u << 10;
constexpr size_t WS_CTL = 0, CTL_ZERO_BYTES = 1 * MiB;
constexpr size_t WS_SSP = 1 * MiB;
constexpr size_t WS_TAB = 2 * MiB;
constexpr size_t WS_TOKE = WS_TAB, WS_TOKG = WS_TAB + 128 * KiB, WS_TOKS = WS_TAB + 256 * KiB, WS_RSTD = WS_TAB + 384 * KiB;
constexpr size_t WS_ROWIDX = WS_TAB + 448 * KiB, WS_RSLOT = WS_TAB + 592 * KiB;
constexpr size_t WS_HIST = WS_TAB + 736 * KiB, WS_TILEE = WS_TAB + 744 * KiB, WS_NTIL = WS_TAB + 745 * KiB, WS_KM = WS_TAB + 768 * KiB;
constexpr size_t WS_E13 = 4 * MiB, WS_E2 = 116 * MiB, WS_HB = 172 * MiB, WS_SW = 204 * MiB;
constexpr size_t WS_WQKV0 = WS_SW, WS_WQKV1 = WS_SW + 6 * MiB, WS_WO0 = WS_SW + 12 * MiB, WS_WO1 = WS_SW + 14 * MiB, WS_W13 = WS_SW + 16 * MiB, WS_W2 = WS_SW + 27 * MiB;
constexpr size_t WS_QO = 237 * MiB, WS_K = 269 * MiB, WS_V = 301 * MiB, WS_HID0 = 237 * MiB;
constexpr size_t WS_H = 204 * MiB;
constexpr size_t WS_Y = 4 * MiB;
constexpr size_t WS_END = 441 * MiB;
static_assert(MAXSLOT * 4 <= 144 * KiB && WS_KM + 128 * 8 * 64 * 4 <= WS_E13, "tables");
static_assert(WS_W2 + (size_t)DM * FF * 2 <= WS_QO && WS_W13 + (size_t)2 * FF * DM * 2 <= WS_W2, "small weights");
static_assert(WS_HID0 + (size_t)M * FF * 2 <= WS_END && WS_H + (size_t)MAXSLOT * FE * 2 <= WS_END && WS_Y + (size_t)MAXSLOT * DM * 2 <= WS_E2, "overlays");
static_assert(WS_E13 + (size_t)NE * 2 * FE * DM * 2 <= WS_E2 && WS_E2 + (size_t)NE * DM * FE * 2 <= WS_HB && WS_HB + (size_t)M * DM * 2 <= WS_SW, "expert weights");
constexpr int CW_TMO = 0, CW_CODE = 1, CW_BAR = 4096;

constexpr int RING_OFF = 0, RING_BYTES = 131072;
constexpr int LDSCTL_OFF = RING_BYTES, MISC_OFF = LDSCTL_OFF + 320;
constexpr int LDS_BYTES = 147456;
static_assert(att::L_BYTES <= RING_BYTES && MISC_OFF + 128 <= LDS_BYTES, "LDS map");

#define XB_TMO      128
#define XB_XCNT(j)  (256  + 64 * (j))
#define XB_XSUB(j)  (1280 + 64 * (j))
#define XB_XGEN(j)  (2304 + 64 * (j))
#define XB_TOP      3328
#define XB_TOPGEN   3392
#define XCD_BAR_WORDS 3456
#define XB_SPIN_CAP (1u << 18)
__device__ __forceinline__ unsigned xb_ld(unsigned* p)              { return __hip_atomic_load(p, __ATOMIC_RELAXED, __HIP_MEMORY_SCOPE_AGENT); }
__device__ __forceinline__ unsigned xb_add(unsigned* p, unsigned v) { return __hip_atomic_fetch_add(p, v, __ATOMIC_RELAXED, __HIP_MEMORY_SCOPE_AGENT); }
__device__ __forceinline__ unsigned xb_xcc_id() { return (unsigned)__builtin_amdgcn_s_getreg((3 << 11) | 20) & 0xFu; }
#define XB_SPIN(cond, bar) do { unsigned _sp = 0; while (cond) { __builtin_amdgcn_s_sleep(1); \
    if ((++_sp & 255u) == 0u) { if (xb_ld(&(bar)[XB_TMO])) break; if (_sp > XB_SPIN_CAP) { atomicAdd(&(bar)[XB_TMO], 1u); break; } } } } while (0)
struct XcdBarrier { unsigned* bar; unsigned x; volatile LAS unsigned* st; };
__device__ __forceinline__ XcdBarrier xcd_barrier_post(unsigned* bar, volatile LAS unsigned* st) {
    XcdBarrier b; b.bar = bar; b.x = xb_xcc_id(); b.st = st;
    if (threadIdx.x == 0) (void)xb_add(&bar[XB_XCNT(b.x)], 1u);
    return b;
}
__device__ __forceinline__ void xcd_barrier_complete(unsigned* bar, unsigned x, unsigned& nloc, unsigned& nx) {
    const unsigned G = gridDim.x * gridDim.y * gridDim.z;
    unsigned sum, cnt, mine, sp = 0u;
    for (;;) {
        sum = 0u; cnt = 0u; mine = 0u;
#pragma unroll
        for (unsigned j = 0; j < 16; ++j) { const unsigned c = xb_ld(&bar[XB_XCNT(j)]); sum += c; cnt += (c > 0u) ? 1u : 0u; mine = (j == x) ? c : mine; }
        if (sum == G) break;
        __builtin_amdgcn_s_sleep(1);
        if ((++sp & 255u) == 0u) { if (xb_ld(&bar[XB_TMO])) break; if (sp > XB_SPIN_CAP) { atomicAdd(&bar[XB_TMO], 1u); break; } }
    }
    nloc = mine > 0u ? mine : 1u; nx = cnt > 0u ? cnt : 1u;
}
__device__ __forceinline__ void xcd_barrier(const XcdBarrier& b) {
    asm volatile("s_waitcnt vmcnt(0)" ::: "memory");
    __syncthreads();
    if (threadIdx.x == 0) {
        unsigned* bar = b.bar;
        __builtin_amdgcn_s_waitcnt(0);
        unsigned nloc = b.st[0], nx = b.st[1];
        if (nloc == 0u) { xcd_barrier_complete(bar, b.x, nloc, nx); b.st[0] = nloc; b.st[1] = nx; }
        const unsigned old = xb_add(&bar[XB_XSUB(b.x)], 1u);
        const unsigned gen = old / nloc;
        if (old + 1u == (gen + 1u) * nloc) {
            __builtin_amdgcn_fence(__ATOMIC_RELEASE, "agent");
            asm volatile("s_waitcnt vmcnt(0)" ::: "memory");
            const unsigned og = xb_add(&bar[XB_TOP], 1u);
            const unsigned tg = og / nx;
            if (og + 1u == (tg + 1u) * nx) xb_add(&bar[XB_TOPGEN], 1u);
            else XB_SPIN(xb_ld(&bar[XB_TOPGEN]) == tg, bar);
            __builtin_amdgcn_fence(__ATOMIC_ACQUIRE, "agent");
            xb_add(&bar[XB_XGEN(b.x)], 1u);
            asm volatile("s_waitcnt vmcnt(0)" ::: "memory");
        } else {
            XB_SPIN(xb_ld(&bar[XB_XGEN(b.x)]) == gen, bar);
            __builtin_amdgcn_fence(__ATOMIC_ACQUIRE, "agent");
            asm volatile("s_waitcnt vmcnt(0)" ::: "memory");
        }
    }
    __syncthreads();
}

struct Args { const float* in[14]; float* out; unsigned char* ws; };
struct Frame { LAS unsigned char* lds; int tid, lane, wave, vcu, G; };

__device__ __forceinline__ void cvt_item(const float* W, int K, int N, const float* g, bf16_t* WT, int mode, int item, int lane) {
    const int nblk = N / 32, kb = item / nblk, nb = item - kb * nblk, k0 = 64 * kb, n0 = 32 * nb;
    const int nq = lane & 7, ko = lane >> 3;
    const float* src = W + (size_t)(k0 + 8 * ko) * N + n0 + 4 * nq;
    f32x4 v[8];
#pragma unroll
    for (int jj = 0; jj < 8; ++jj) v[jj] = __builtin_nontemporal_load((const f32x4*)(src + (size_t)jj * N));
    if (g) { const f32x4 g0 = *(const f32x4*)(g + k0 + 8 * ko), g1 = *(const f32x4*)(g + k0 + 8 * ko + 4);
#pragma unroll
        for (int jj = 0; jj < 4; ++jj) { v[jj] = v[jj] * g0[jj]; v[4 + jj] = v[4 + jj] * g1[jj]; } }
#pragma unroll
    for (int i = 0; i < 4; ++i) { const int n = n0 + 4 * nq + i; const int row = mode == 0 ? n : (256 * (n >> 7) + (n & 127) + (mode == 2 ? 128 : 0));
        u32x4 o; o.x = cvtpk(v[0][i], v[1][i]); o.y = cvtpk(v[2][i], v[3][i]); o.z = cvtpk(v[4][i], v[5][i]); o.w = cvtpk(v[6][i], v[7][i]);
        *(u32x4*)(WT + (size_t)row * K + k0 + 8 * ko) = o; }
}
__device__ __forceinline__ void p0_prologue(const Frame& F, const Args& a) {
    unsigned char* ws = a.ws;
    const float* w_qkv = a.in[1]; const float* w_o = a.in[2]; const float* mixer_norm = a.in[3]; const float* ffn_norm = a.in[4];
    const float* w1 = a.in[6]; const float* w3 = a.in[7]; const float* w2 = a.in[8]; const float* e_w1 = a.in[10]; const float* e_w3 = a.in[11]; const float* e_w2 = a.in[12];
    const int gw = F.vcu * NWAVES + F.wave, NGW = F.G * NWAVES;
    constexpr int I_QKV = 16 * 96, I_O = 16 * 32, I_13 = 16 * 88, I_2 = 44 * 32, I_E13 = 16 * 112, I_E2 = 56 * 32;
    constexpr int NITEMS = 2 * I_QKV + 2 * I_O + 2 * I_13 + I_2 + 16 * I_E13 + 8 * I_E2;
    for (int it = gw; it < NITEMS; it += NGW) {
        int r = it;
        if (r < 2 * I_QKV) { const int l = r / I_QKV; r -= l * I_QKV; cvt_item(w_qkv + (size_t)l * DM * NQKV, DM, NQKV, mixer_norm + l * DM, (bf16_t*)(ws + (l ? WS_WQKV1 : WS_WQKV0)), 0, r, F.lane); continue; } r -= 2 * I_QKV;
        if (r < 2 * I_O) { const int l = r / I_O; r -= l * I_O; cvt_item(w_o + (size_t)l * DM * DM, DM, DM, nullptr, (bf16_t*)(ws + (l ? WS_WO1 : WS_WO0)), 0, r, F.lane); continue; } r -= 2 * I_O;
        if (r < I_13) { cvt_item(w1, DM, FF, ffn_norm, (bf16_t*)(ws + WS_W13), 1, r, F.lane); continue; } r -= I_13;
        if (r < I_13) { cvt_item(w3, DM, FF, ffn_norm, (bf16_t*)(ws + WS_W13), 2, r, F.lane); continue; } r -= I_13;
        if (r < I_2) { cvt_item(w2, FF, DM, nullptr, (bf16_t*)(ws + WS_W2), 0, r, F.lane); continue; } r -= I_2;
        if (r < 8 * I_E13) { const int e = r / I_E13; r -= e * I_E13; cvt_item(e_w1 + (size_t)e * DM * FE, DM, FE, ffn_norm + DM, (bf16_t*)(ws + WS_E13) + (size_t)e * 2 * FE * DM, 1, r, F.lane); continue; } r -= 8 * I_E13;
        if (r < 8 * I_E13) { const int e = r / I_E13; r -= e * I_E13; cvt_item(e_w3 + (size_t)e * DM * FE, DM, FE, ffn_norm + DM, (bf16_t*)(ws + WS_E13) + (size_t)e * 2 * FE * DM, 2, r, F.lane); continue; } r -= 8 * I_E13;
        { const int e = r / I_E2; r -= e * I_E2; cvt_item(e_w2 + (size_t)e * FE * DM, FE, DM, nullptr, (bf16_t*)(ws + WS_E2) + (size_t)e * DM * FE, 0, r, F.lane); }
    }
    const float* x = a.in[0]; bf16_t* HB = (bf16_t*)(ws + WS_HB); float* ssp = (float*)(ws + WS_SSP);
    for (int m = gw; m < M; m += NGW) {
        const f32x4* xr = (const f32x4*)(x + (size_t)m * DM) + F.lane; f32x4 v[4]; float s = 0.f;
#pragma unroll
        for (int j = 0; j < 4; ++j) { v[j] = xr[64 * j]; s += (v[j][0] * v[j][0] + v[j][1] * v[j][1]) + (v[j][2] * v[j][2] + v[j][3] * v[j][3]); }
        s = wave_sum(s);
        u32x2* o8 = (u32x2*)(HB + (size_t)m * DM) + F.lane;
#pragma unroll
        for (int j = 0; j < 4; ++j) { u32x2 w; w.x = cvtpk(v[j][0], v[j][1]); w.y = cvtpk(v[j][2], v[j][3]); o8[64 * j] = w; }
        if (F.lane < 16) ssp[(size_t)m * 16 + F.lane] = F.lane == 0 ? s : 0.f;
    }
}
__device__ __forceinline__ void kmean_phase(const Frame& F, const bf16_t* Kb, float* km) {
    const int gw = F.vcu * NWAVES + F.wave, NGW = F.G * NWAVES;
    for (int it = gw; it < NB * NH * 8; it += NGW) {
        const int n = it & 7, bh = it >> 3, b = bh >> 4, h = bh & 15;
        const bf16_t* src = Kb + ((size_t)b * SEQ + 256 * n + (F.lane >> 3)) * DM + h * HD + (F.lane & 7) * 8;
        float s[8];
#pragma unroll
        for (int j = 0; j < 8; ++j) s[j] = 0.f;
#pragma unroll 8
        for (int p = 0; p < 32; ++p) { const bf16x8 v = *(const bf16x8*)(src + (size_t)p * 8 * DM);
#pragma unroll
            for (int j = 0; j < 8; ++j) s[j] += bf2f((unsigned short)v[j]); }
#pragma unroll
        for (int j = 0; j < 8; ++j) { s[j] += __shfl_xor(s[j], 8); s[j] += __shfl_xor(s[j], 16); s[j] += __shfl_xor(s[j], 32); }
        if (F.lane < 8) { float* o = km + (size_t)it * 64 + F.lane * 8;
#pragma unroll
            for (int j = 0; j < 8; ++j) o[j] = s[j] * (1.0f / 256.0f); }
    }
}
__device__ __forceinline__ void router_phase(const Frame& F, const Args& a) {
    unsigned char* ws = a.ws; const float* hres = a.out; const float* router = a.in[9]; const float* g = a.in[4] + DM;
    LAS float* rw = (LAS float*)(F.lds);
    LAS int* cnt = (LAS int*)(F.lds + 32768);
    for (int i = F.tid; i < DM * NE; i += NWAVES * 64) rw[i] = router[i] * g[i >> 3];
    if (F.tid < NE) cnt[F.tid] = 0;
    __syncthreads();
    int* tok_e = (int*)(ws + WS_TOKE); float* tok_g = (float*)(ws + WS_TOKG); float* rstd_t = (float*)(ws + WS_RSTD);
    const int c = blockIdx.x;
    for (int i = 0; i < 8; ++i) {
        const int row = 64 * c + 8 * F.wave + i;
        if (row >= M) break;
        const float* hr = hres + (size_t)row * DM;
        float lg[8]; float ss = 0.f;
#pragma unroll
        for (int e = 0; e < 8; ++e) lg[e] = 0.f;
#pragma unroll
        for (int j = 0; j < 16; ++j) { const int k = F.lane + 64 * j; const float hv = hr[k]; ss += hv * hv;
            const LAS f32x4* rp = (const LAS f32x4*)(rw + k * 8); const f32x4 r0 = rp[0], r1 = rp[1];
            lg[0] += hv * r0[0]; lg[1] += hv * r0[1]; lg[2] += hv * r0[2]; lg[3] += hv * r0[3]; lg[4] += hv * r1[0]; lg[5] += hv * r1[1]; lg[6] += hv * r1[2]; lg[7] += hv * r1[3]; }
        ss = wave_sum(ss); const float rstd = 1.0f / sqrtf(ss * (1.0f / DM) + RMS_EPS);
#pragma unroll
        for (int e = 0; e < 8; ++e) lg[e] = wave_sum(lg[e]) * rstd;
        int e1 = 0; float v1 = lg[0];
#pragma unroll
        for (int e = 1; e < 8; ++e) if (lg[e] > v1) { v1 = lg[e]; e1 = e; }
        int e2 = -1; float v2 = -INFINITY;
#pragma unroll
        for (int e = 0; e < 8; ++e) if (e != e1 && (e2 < 0 || lg[e] > v2)) { v2 = lg[e]; e2 = e; }
        const float ex = __expf(v2 - v1); const float w1 = 1.0f / (1.0f + ex), w2 = ex / (1.0f + ex);
        if (F.lane == 0) { tok_e[2 * row] = e1; tok_e[2 * row + 1] = e2; tok_g[2 * row] = w1; tok_g[2 * row + 1] = w2; rstd_t[row] = rstd;
            __hip_atomic_fetch_add(&cnt[e1], 1, __ATOMIC_RELAXED, __HIP_MEMORY_SCOPE_WORKGROUP); __hip_atomic_fetch_add(&cnt[e2], 1, __ATOMIC_RELAXED, __HIP_MEMORY_SCOPE_WORKGROUP); }
    }
    __syncthreads();
    if (F.tid < NE && c < 256) ((int*)(ws + WS_HIST))[c * 8 + F.tid] = cnt[F.tid];
    __syncthreads();
}
__device__ __forceinline__ void assign_phase(const Frame& F, const Args& a) {
    unsigned char* ws = a.ws;
    LAS int* H = (LAS int*)(F.lds);
    LAS int* tot = H + 2048; LAS int* bef = tot + 8; LAS int* tst = bef + 8; LAS int* ntl = tst + 16;
    const int c = blockIdx.x;
    const int* hist = (const int*)(ws + WS_HIST);
    for (int i = F.tid; i < 2048; i += NWAVES * 64) H[i] = __hip_atomic_load(hist + i, __ATOMIC_RELAXED, __HIP_MEMORY_SCOPE_AGENT);
    __syncthreads();
    if (F.tid < NE) { int t = 0, bb = 0; for (int b2 = 0; b2 < 256; ++b2) { const int v = H[b2 * 8 + F.tid]; if (b2 < c) bb += v; t += v; } tot[F.tid] = t; bef[F.tid] = bb; }
    __syncthreads();
    if (F.tid == 0) { int s = 0; for (int e = 0; e < NE; ++e) { const int nt = (tot[e] + 255) >> 8; tst[e] = s; ntl[e] = nt; s += nt; } tst[8] = s; }
    __syncthreads();
    const int* tok_e = (const int*)(ws + WS_TOKE); int* tok_s = (int*)(ws + WS_TOKS); const float* rstd_t = (const float*)(ws + WS_RSTD);
    int* rowidx = (int*)(ws + WS_ROWIDX); float* rslot = (float*)(ws + WS_RSLOT);
    if (F.tid < NE && c < 256) { const int e = F.tid; int pos = 256 * tst[e] + bef[e];
        for (int i = 0; i < 64; ++i) { const int row = 64 * c + i;
            for (int k = 0; k < 2; ++k) if (tok_e[2 * row + k] == e) { rowidx[pos] = row; rslot[pos] = rstd_t[row]; tok_s[2 * row + k] = pos; ++pos; } } }
    if (c < NE) { const int e = c; const int lo = 256 * tst[e] + tot[e], hi2 = 256 * (tst[e] + ntl[e]);
        for (int s = lo + F.tid; s < hi2; s += NWAVES * 64) { rowidx[s] = 0; rslot[s] = 0.f; } }
    if (c == 0) { int* tile_e = (int*)(ws + WS_TILEE);
        if (F.tid < MAXT) { int e = 0; for (int q = 0; q < NE; ++q) if (F.tid >= tst[q] && F.tid < tst[q] + ntl[q]) e = q; tile_e[F.tid] = e; }
        if (F.tid == 0) *(int*)(ws + WS_NTIL) = tst[8]; }
    __syncthreads();
}
__device__ __forceinline__ void combine_phase(const Frame& F, const Args& a, bool poison) {
    unsigned char* ws = a.ws; float* out = a.out; const float* gfin = a.in[13];
    const int* tok_s = (const int*)(ws + WS_TOKS); const float* tok_g = (const float*)(ws + WS_TOKG); const bf16_t* Y = (const bf16_t*)(ws + WS_Y);
    const int gw = F.vcu * NWAVES + F.wave, NGW = F.G * NWAVES;
    f32x4 gf[4];
#pragma unroll
    for (int j = 0; j < 4; ++j) gf[j] = ((const f32x4*)gfin)[F.lane + 64 * j];
    for (int m = gw; m < M; m += NGW) {
        const int s1 = tok_s[2 * m], s2 = tok_s[2 * m + 1]; const float w1 = tok_g[2 * m], w2 = tok_g[2 * m + 1];
        f32x4* hr = (f32x4*)(out + (size_t)m * DM) + F.lane;
        const u32x2* y1 = (const u32x2*)(Y + (size_t)s1 * DM) + F.lane; const u32x2* y2 = (const u32x2*)(Y + (size_t)s2 * DM) + F.lane;
        f32x4 v[4]; float ss = 0.f;
#pragma unroll
        for (int j = 0; j < 4; ++j) { const f32x4 hv = hr[64 * j]; const u32x2 a1 = y1[64 * j], a2 = y2[64 * j];
            v[j][0] = hv[0] + w1 * __uint_as_float(a1.x << 16) + w2 * __uint_as_float(a2.x << 16);
            v[j][1] = hv[1] + w1 * __uint_as_float(a1.x & 0xffff0000u) + w2 * __uint_as_float(a2.x & 0xffff0000u);
            v[j][2] = hv[2] + w1 * __uint_as_float(a1.y << 16) + w2 * __uint_as_float(a2.y << 16);
            v[j][3] = hv[3] + w1 * __uint_as_float(a1.y & 0xffff0000u) + w2 * __uint_as_float(a2.y & 0xffff0000u);
            ss += (v[j][0] * v[j][0] + v[j][1] * v[j][1]) + (v[j][2] * v[j][2] + v[j][3] * v[j][3]); }
        ss = wave_sum(ss); float rstd = 1.0f / sqrtf(ss * (1.0f / DM) + RMS_EPS);
        if (poison) rstd = __builtin_nanf("");
#pragma unroll
        for (int j = 0; j < 4; ++j) hr[64 * j] = v[j] * rstd * gf[j];
    }
}

__global__ void __launch_bounds__(NWAVES * 64, 2) mega_fwd(Args args) {
    extern __shared__ __attribute__((aligned(16))) unsigned char lds[];
    Frame F;
    F.lds = (LAS unsigned char*)lds;
    F.tid = threadIdx.x; F.lane = F.tid & 63; F.wave = __builtin_amdgcn_readfirstlane(F.tid >> 6);
    F.G = gridDim.x; { const int bx = blockIdx.x; F.vcu = (F.G % 8 == 0) ? (bx % 8) * (F.G / 8) + bx / 8 : bx; }
    unsigned char* ws = args.ws;
    gu32* ctl = (gu32*)(ws + WS_CTL);
    for (int u = F.tid; u < (LDS_BYTES - LDSCTL_OFF) / 4; u += NWAVES * 64) ((LAS unsigned*)(F.lds + LDSCTL_OFF))[u] = 0u;
    __syncthreads();
    XcdBarrier bar = xcd_barrier_post((unsigned*)(ctl + CW_BAR), (volatile LAS unsigned*)(F.lds + MISC_OFF) + 8);
#define GRID_BAR() xcd_barrier(bar)
    bf16_t* HB = (bf16_t*)(ws + WS_HB); float* ssp = (float*)(ws + WS_SSP);
    bf16_t* QO = (bf16_t*)(ws + WS_QO); bf16_t* KB = (bf16_t*)(ws + WS_K); bf16_t* VB = (bf16_t*)(ws + WS_V);
    LAS unsigned char* ring = F.lds + RING_OFF;
    const int bx = (int)blockIdx.x;

    p0_prologue(F, args);
    GRID_BAR();
    {
        pg8::Gemm g{HB, (const bf16_t*)(ws + WS_WQKV0), M, NQKV, DM, nullptr, nullptr, 0}; pg8::StaticOrder S; S.init(M, NQKV, F.G, bx);
        pg8::EpiBf16<16> E{QO, DM, DM, (size_t)(WS_K - WS_QO) / 2, C2, ssp};
        pg8::gemm_phase<pg8::EpiBf16<16>, false, false>(ring, g, S, E);
    }
    GRID_BAR();
    {
        for (int i = 0; i < 4; ++i) { const int uid = F.vcu * 4 + i; if (uid >= NB * NH * 8) break; const int bh = uid >> 3, qb = uid & 7;
            att::sb_unit(bh >> 4, bh & 15, qb, QO, KB, VB, QO, (LAS char*)ring); }
    }
    GRID_BAR();
    {
        pg8::Gemm g{QO, (const bf16_t*)(ws + WS_WO0), M, DM, DM, nullptr, nullptr, 0}; pg8::StaticOrder S; S.init(M, DM, F.G, bx);
        pg8::EpiRes E{args.in[0], args.out, HB, ssp};
        pg8::gemm_phase<pg8::EpiRes, false, false>(ring, g, S, E);
    }
    GRID_BAR();
    {
        pg8::Gemm g{HB, (const bf16_t*)(ws + WS_W13), M, 2 * FF, DM, nullptr, nullptr, 0}; pg8::StaticOrder S; S.init(M, 2 * FF, F.G, bx);
        pg8::EpiSwiglu<16> E{(bf16_t*)(ws + WS_HID0), FF, ssp};
        pg8::gemm_phase<pg8::EpiSwiglu<16>, false, false>(ring, g, S, E);
    }
    GRID_BAR();
    {
        pg8::Gemm g{(const bf16_t*)(ws + WS_HID0), (const bf16_t*)(ws + WS_W2), M, DM, FF, nullptr, nullptr, 0}; pg8::StaticOrder S; S.init(M, DM, F.G, bx);
        pg8::EpiRes E{args.out, args.out, HB, ssp};
        pg8::gemm_phase<pg8::EpiRes, false, false>(ring, g, S, E);
    }
    GRID_BAR();
    {
        pg8::Gemm g{HB, (const bf16_t*)(ws + WS_WQKV1), M, NQKV, DM, nullptr, nullptr, 0}; pg8::StaticOrder S; S.init(M, NQKV, F.G, bx);
        pg8::EpiBf16<16> E{QO, DM, DM, (size_t)(WS_K - WS_QO) / 2, C2, ssp};
        pg8::gemm_phase<pg8::EpiBf16<16>, false, false>(ring, g, S, E);
    }
    GRID_BAR();
    kmean_phase(F, KB, (float*)(ws + WS_KM));
    GRID_BAR();
    {
        if (F.G == 256) { const int bh = F.vcu >> 1, hf = F.vcu & 1;
            for (int i = 0; i < 4; ++i) { const int own = hf ? (i == 0 ? 1 : i == 1 ? 6 : i == 2 ? 2 : 5) : (i == 0 ? 0 : i == 1 ? 7 : i == 2 ? 3 : 4);
                att::moba_unit(bh >> 4, bh & 15, own, QO, KB, VB, QO, (const float*)(ws + WS_KM), args.in[5], (LAS char*)ring); } }
    }
    GRID_BAR();
    {
        pg8::Gemm g{QO, (const bf16_t*)(ws + WS_WO1), M, DM, DM, nullptr, nullptr, 0}; pg8::StaticOrder S; S.init(M, DM, F.G, bx);
        pg8::EpiRes E{args.out, args.out, HB, ssp};
        pg8::gemm_phase<pg8::EpiRes, false, false>(ring, g, S, E);
    }
    GRID_BAR();
    if (F.G == 256) router_phase(F, args);
    GRID_BAR();
    if (F.G == 256) assign_phase(F, args);
    GRID_BAR();
    const int ntiles = __builtin_amdgcn_readfirstlane(__hip_atomic_load((int*)(ws + WS_NTIL), __ATOMIC_RELAXED, __HIP_MEMORY_SCOPE_AGENT));
    {
        pg8::Gemm g{HB, (const bf16_t*)(ws + WS_E13), ntiles * 256, 2 * FE, DM, (const int*)(ws + WS_ROWIDX), (const int*)(ws + WS_TILEE), (size_t)2 * FE * DM}; pg8::StaticOrder S; S.init(ntiles * 256, 2 * FE, F.G, bx);
        pg8::EpiSwiglu<1> E{(bf16_t*)(ws + WS_H), FE, (const float*)(ws + WS_RSLOT)};
        pg8::gemm_phase<pg8::EpiSwiglu<1>, true, true>(ring, g, S, E);
    }
    GRID_BAR();
    {
        pg8::Gemm g{(const bf16_t*)(ws + WS_H), (const bf16_t*)(ws + WS_E2), ntiles * 256, DM, FE, nullptr, (const int*)(ws + WS_TILEE), (size_t)DM * FE}; pg8::StaticOrder S; S.init(ntiles * 256, DM, F.G, bx);
        pg8::EpiBf16<1> E{(bf16_t*)(ws + WS_Y), DM, 0, 0, 1.f, nullptr};
        pg8::gemm_phase<pg8::EpiBf16<1>, false, true>(ring, g, S, E);
    }
    GRID_BAR();
    {
        bool poison = (__hip_atomic_load(ctl + CW_BAR + XB_TMO, __ATOMIC_RELAXED, __HIP_MEMORY_SCOPE_AGENT) != 0u) || (F.G != 256);
        combine_phase(F, args, poison);
    }
}

extern "C" void kernel_launch(void* const* d_in, const int* in_sizes, int n_in, void* d_out, int out_size, void* d_ws, size_t ws_size, hipStream_t stream) {
    static int grid = 0;
    if (grid == 0) {
        if (n_in != 14 || in_sizes[0] != M * DM || out_size != M * DM || ws_size < WS_END) { fprintf(stderr, "kernel_launch: unexpected shapes or workspace (%zu < %zu); nothing launched\n", ws_size, (size_t)WS_END); grid = -1; return; }
        int dev = 0, cus = 0, per_cu = 0;
        if (hipGetDevice(&dev) != hipSuccess || hipDeviceGetAttribute(&cus, hipDeviceAttributeMultiprocessorCount, dev) != hipSuccess) { grid = -1; return; }
        if (hipFuncSetAttribute((const void*)mega_fwd, hipFuncAttributeMaxDynamicSharedMemorySize, LDS_BYTES) != hipSuccess) { fprintf(stderr, "kernel_launch: hipFuncSetAttribute failed\n"); grid = -1; return; }
        if (hipOccupancyMaxActiveBlocksPerMultiprocessor(&per_cu, (const void*)mega_fwd, NWAVES * 64, LDS_BYTES) != hipSuccess || per_cu < 1) { fprintf(stderr, "kernel_launch: occupancy query reports %d\n", per_cu); }
        (void)hipGetLastError();
        grid = cus;
    }
    if (grid < 0) return;
    if (hipMemsetAsync((char*)d_ws + WS_CTL, 0, CTL_ZERO_BYTES, stream) != hipSuccess) return;
    Args a{};
    for (int i = 0; i < 14; ++i) a.in[i] = (const float*)d_in[i];
    a.out = (float*)d_out; a.ws = (unsigned char*)d_ws;
    hipLaunchKernelGGL(mega_fwd, dim3(grid), dim3(NWAVES * 64), LDS_BYTES, stream, a);
}
```

```cpp
#include <hip/hip_runtime.h>
#include <cstdio>
#include <cstdint>

#define GAS __attribute__((address_space(1)))
#define LAS __attribute__((address_space(3)))
typedef unsigned short bf16_t;
typedef short bf16x8 __attribute__((ext_vector_type(8)));
typedef short s16x4 __attribute__((ext_vector_type(4)));
typedef short v4i16_t __attribute__((ext_vector_type(4)));
typedef float f32x4 __attribute__((ext_vector_type(4)));
typedef float f32x16 __attribute__((ext_vector_type(16)));
typedef unsigned u32x4 __attribute__((ext_vector_type(4)));
typedef unsigned u32x2 __attribute__((ext_vector_type(2)));
typedef float f32x2_t __attribute__((ext_vector_type(2)));
typedef __bf16 bf16x2_t __attribute__((ext_vector_type(2)));
typedef GAS unsigned gu32;

constexpr int NB = 8, SEQ = 2048, DM = 1024, NH = 16, HD = 64, M = NB * SEQ;
constexpr int FF = 2816, NE = 8, FE = 3584, NQKV = 3 * DM;
constexpr int MAXT = 135, MAXSLOT = MAXT * 256;
constexpr float RMS_EPS = 1e-6f;
constexpr float LOG2E = 1.4426950408889634f;
constexpr float C2 = 0.125f * LOG2E;
constexpr int NWAVES = 8;
#define PROBE 0

__device__ __forceinline__ unsigned cvtpk(float lo, float hi) { f32x2_t v = {lo, hi}; bf16x2_t b = __builtin_convertvector(v, bf16x2_t); return __builtin_bit_cast(unsigned, b); }
__device__ __forceinline__ float bf2f(unsigned short x) { return __uint_as_float((unsigned)x << 16); }
__device__ __forceinline__ float wave_sum(float v) {
#pragma unroll
    for (int o = 1; o < 64; o <<= 1) v += __shfl_xor(v, o);
    return v;
}

namespace pg8 {
constexpr int BM = 256, BK = 64, HALF = 128, HTB = HALF * BK * 2, STAGE_BYTES = 8 * HTB, NXCD = 8, WGM = 8;
__host__ __device__ __forceinline__ int lds_byte(int r, int c) { const int st = (r >> 4) * 2 + (c >> 5), rr = r & 15, cc = c & 31, ob = rr * 64 + cc * 2; return st * 1024 + (ob ^ (((ob >> 9) & 1) << 5)); }
__host__ __device__ __forceinline__ void stage_rc(int b, int& R, int& C) { const int st = b / 1024, sb = b % 1024, swz = sb ^ (((sb >> 9) & 1) << 5); R = (st >> 1) * 16 + swz / 64; C = (st & 1) * 32 + (swz % 64) / 2; }
__host__ __device__ __forceinline__ int perm32(int rho) { const int n = rho >> 4, i = rho & 15; return 8 * (i >> 2) + 4 * n + (i & 3); }

struct Unit { int pm, pn; };
struct Gemm { const bf16_t* A; const bf16_t* Bt; int M, N, K; const int* rowidx; const int* tile_e; size_t estride; };

struct StaticOrder {
    int nM, nN, nwg, G, c;
    __host__ __device__ void init(int M_, int N_, int G_, int c_) { nM = M_ / BM; nN = N_ / BM; nwg = nM * nN; G = G_; c = c_; }
    __host__ __device__ bool next(int i, Unit& u) const {
        const long L = (long)i * G + c; if (L >= nwg) return false;
        int wgid = (int)L; { const int q = nwg / NXCD, r = nwg % NXCD, xcd = wgid % NXCD, off = wgid / NXCD; wgid = (xcd < r ? xcd * (q + 1) : r * (q + 1) + (xcd - r) * q) + off; }
        const int nig = WGM * nN, gid = wgid / nig, fm = gid * WGM, gsz = (nM - fm) < WGM ? (nM - fm) : WGM;
        u.pm = fm + ((wgid % nig) % gsz); u.pn = (wgid % nig) / gsz; return true;
    }
};

template <int NP> struct RowScale {
    const float* p;
    __device__ __forceinline__ float get(int row) const {
        if constexpr (NP == 16) { const f32x4* q = (const f32x4*)(p + (size_t)row * 16); const f32x4 a = q[0], b = q[1], c = q[2], d = q[3];
            const float s = ((a[0] + a[1]) + (a[2] + a[3])) + ((b[0] + b[1]) + (b[2] + b[3])) + ((c[0] + c[1]) + (c[2] + c[3])) + ((d[0] + d[1]) + (d[2] + d[3]));
            return __builtin_amdgcn_rsqf(s * (1.0f / DM) + RMS_EPS); }
        else return p[row];
    }
};

template <int NP> struct EpiBf16 {
    static constexpr bool PERM = true;
    bf16_t* O; int ldc; int split_cols; size_t split_stride; float scale0; const float* rs;
    __device__ __forceinline__ void operator()(const f32x4 (&acc)[2][2][4][2], const Unit& u, int wr, int wc, int fr, int fq) const {
        const int row0 = u.pm * BM + wr * 64 + fr; int colt = u.pn * BM; bf16_t* base = O;
        float sc = 1.f; if (split_cols) { const int t = colt / split_cols; base += (size_t)t * split_stride; colt -= t * split_cols; if (t == 0) sc = scale0; }
        const int col0 = colt + wc * 32 + 8 * fq;
        const RowScale<NP> R{rs};
#pragma unroll
        for (int ai = 0; ai < 2; ++ai)
#pragma unroll
            for (int m = 0; m < 4; ++m) { const int row = row0 + ai * HALF + m * 16; bf16_t* rowp = base + (size_t)row * ldc + col0;
                const float s = rs ? R.get(row) * sc : sc;
#pragma unroll
                for (int bj = 0; bj < 2; ++bj) { const f32x4 v0 = acc[ai][bj][m][0] * s, v1 = acc[ai][bj][m][1] * s;
                    u32x4 w; w.x = cvtpk(v0[0], v0[1]); w.y = cvtpk(v0[2], v0[3]); w.z = cvtpk(v1[0], v1[1]); w.w = cvtpk(v1[2], v1[3]);
                    *(u32x4*)(rowp + bj * HALF) = w; } }
    }
};
template <int NP> struct EpiSwiglu {
    static constexpr bool PERM = true;
    bf16_t* O; int ldc; const float* rs;
    __device__ __forceinline__ void operator()(const f32x4 (&acc)[2][2][4][2], const Unit& u, int wr, int wc, int fr, int fq) const {
        const int row0 = u.pm * BM + wr * 64 + fr; const int col0 = u.pn * HALF + wc * 32 + 8 * fq;
        const RowScale<NP> R{rs};
#pragma unroll
        for (int ai = 0; ai < 2; ++ai)
#pragma unroll
            for (int m = 0; m < 4; ++m) { const int row = row0 + ai * HALF + m * 16; const float r = R.get(row);
                float hv[8];
#pragma unroll
                for (int n = 0; n < 2; ++n)
#pragma unroll
                    for (int e = 0; e < 4; ++e) { const float g = acc[ai][0][m][n][e] * r, uu = acc[ai][1][m][n][e] * r;
                        const float sg = __builtin_amdgcn_rcpf(1.0f + __builtin_amdgcn_exp2f(-g * LOG2E));
                        hv[n * 4 + e] = g * sg * uu; }
                u32x4 w; w.x = cvtpk(hv[0], hv[1]); w.y = cvtpk(hv[2], hv[3]); w.z = cvtpk(hv[4], hv[5]); w.w = cvtpk(hv[6], hv[7]);
                *(u32x4*)(O + (size_t)row * ldc + col0) = w; }
    }
};
struct EpiRes {
    static constexpr bool PERM = true;
    const float* base; float* out; bf16_t* hb; float* ssp;
    __device__ __forceinline__ void operator()(const f32x4 (&acc)[2][2][4][2], const Unit& u, int wr, int wc, int fr, int fq) const {
        const int row0 = u.pm * BM + wr * 64 + fr; const int col0 = u.pn * BM + wc * 32 + 8 * fq;
#pragma unroll
        for (int ai = 0; ai < 2; ++ai)
#pragma unroll
            for (int m = 0; m < 4; ++m) { const int row = row0 + ai * HALF + m * 16; const size_t off = (size_t)row * DM + col0; float ss = 0.f;
#pragma unroll
                for (int bj = 0; bj < 2; ++bj) { const f32x4 b0 = *(const f32x4*)(base + off + bj * HALF), b1 = *(const f32x4*)(base + off + bj * HALF + 4);
                    const f32x4 v0 = acc[ai][bj][m][0] + b0, v1 = acc[ai][bj][m][1] + b1;
                    *(f32x4*)(out + off + bj * HALF) = v0; *(f32x4*)(out + off + bj * HALF + 4) = v1;
                    u32x4 w; w.x = cvtpk(v0[0], v0[1]); w.y = cvtpk(v0[2], v0[3]); w.z = cvtpk(v1[0], v1[1]); w.w = cvtpk(v1[2], v1[3]);
                    *(u32x4*)(hb + off + bj * HALF) = w;
                    ss += ((v0[0] * v0[0] + v0[1] * v0[1]) + (v0[2] * v0[2] + v0[3] * v0[3])) + ((v1[0] * v1[0] + v1[1] * v1[1]) + (v1[2] * v1[2] + v1[3] * v1[3])); }
                ss += __shfl_xor(ss, 16); ss += __shfl_xor(ss, 32);
                if (fq == 0) ssp[(size_t)row * 16 + u.pn * 4 + wc] = ss; }
    }
};

template <class Epi, bool GATHER, bool EXPB>
__device__ __forceinline__ void gemm_phase(LAS unsigned char* lds, const Gemm g, const StaticOrder& S, const Epi& E) {
    int tid = threadIdx.x; asm volatile("" : "+v"(tid));
    const int wid = __builtin_amdgcn_readfirstlane(tid >> 6), lane = tid & 63, wr = wid >> 2, wc = wid & 3, fr = lane & 15, fq = lane >> 4;
    const int K = g.K, nt = K / BK;
    const size_t kstep = (size_t)(BK * 2);
    const size_t hstep = (size_t)HALF * K * 2;
    const size_t tstep = 2 * hstep;
    int Rr[2], Cc[2]; unsigned voffB[2];
    unsigned vA[2][2], vN[2][2];
#pragma unroll
    for (int i = 0; i < 2; ++i) { int R, C; stage_rc(tid * 16 + i * 8192, R, C); Rr[i] = R; Cc[i] = C; const int Rb = Epi::PERM ? ((R & ~31) + perm32(R & 31)) : R;
        voffB[i] = (unsigned)(Rb * K + C) * 2u;
        vA[0][i] = (unsigned)(R * K + C) * 2u; vA[1][i] = vA[0][i] + (unsigned)hstep; vN[0][i] = vA[0][i]; vN[1][i] = vA[1][i]; }
    const unsigned ldsw = (unsigned)wid * 1024u;
    const int aoff = lds_byte(wr * 64 + fr, fq * 8), boff = lds_byte(wc * 32 + fr, fq * 8);
#define PG8_SA(b, h) (((b) * 2 + (h)) * HTB)
#define PG8_SB(b, h) ((4 + (b) * 2 + (h)) * HTB)
#define PG8_STAGE(bufoff, gbase, voff) do { _Pragma("unroll") for (int _i = 0; _i < 2; ++_i) \
        __builtin_amdgcn_global_load_lds((const unsigned*)((const char*)(gbase) + (voff)[_i]), (LAS unsigned*)(lds + (bufoff) + ldsw + _i * 8192), 16, 0, 0); } while (0)
#define PG8_LDA(dst, b, h) do { _Pragma("unroll") for (int m = 0; m < 4; ++m) _Pragma("unroll") for (int k = 0; k < 2; ++k) dst[m][k] = *(const LAS bf16x8*)(lds + PG8_SA(b, h) + aoff + m * 2048 + k * 1024); } while (0)
#define PG8_LDB(dst, b, h) do { _Pragma("unroll") for (int n = 0; n < 2; ++n) _Pragma("unroll") for (int k = 0; k < 2; ++k) dst[n][k] = *(const LAS bf16x8*)(lds + PG8_SB(b, h) + boff + n * 2048 + k * 1024); } while (0)
#define PG8_MMA(ai, bj, At, Bt) do { __builtin_amdgcn_s_setprio(1); _Pragma("unroll") for (int m = 0; m < 4; ++m) _Pragma("unroll") for (int n = 0; n < 2; ++n) _Pragma("unroll") for (int k = 0; k < 2; ++k) \
        acc[ai][bj][m][n] = __builtin_amdgcn_mfma_f32_16x16x32_bf16(Bt[n][k], At[m][k], acc[ai][bj][m][n], 0, 0, 0); __builtin_amdgcn_s_setprio(0); } while (0)
#define PG8_WAIT_V(n) asm volatile("s_waitcnt vmcnt(" #n ")" ::: "memory")
#define PG8_WAIT_L(n) asm volatile("s_waitcnt lgkmcnt(" #n ")" ::: "memory")
#define PG8_BAR __builtin_amdgcn_s_barrier()
#define PG8_SCHED __builtin_amdgcn_sched_barrier(0)
#define PG8_APTR(u) (GATHER ? (const char*)g.A : (const char*)g.A + (size_t)(u).pm * tstep)
#define PG8_BPTR(u) ((const char*)g.Bt + (EXPB ? (size_t)__builtin_amdgcn_readfirstlane(__hip_atomic_load(g.tile_e + (u).pm, __ATOMIC_RELAXED, __HIP_MEMORY_SCOPE_AGENT)) * g.estride * 2 : (size_t)0) + (size_t)(u).pn * tstep)
#define PG8_GOFF(dst, u) do { _Pragma("unroll") for (int _h = 0; _h < 2; ++_h) _Pragma("unroll") for (int _i = 0; _i < 2; ++_i) \
        dst[_h][_i] = (unsigned)g.rowidx[(u).pm * BM + _h * HALF + Rr[_i]] * (unsigned)(K * 2) + (unsigned)(Cc[_i] * 2); } while (0)
    Unit cur, nxt; int ui = 0;
    if (!S.next(0, cur)) return;
    f32x4 acc[2][2][4][2];
#pragma unroll
    for (int a = 0; a < 2; ++a)
#pragma unroll
        for (int b = 0; b < 2; ++b)
#pragma unroll
            for (int m = 0; m < 4; ++m)
#pragma unroll
                for (int n = 0; n < 2; ++n) acc[a][b][m][n] = (f32x4){0.f, 0.f, 0.f, 0.f};
    bf16x8 At[4][2], B0[2][2], B1[2][2];
    const char* cA = PG8_APTR(cur); const char* cB = PG8_BPTR(cur);
    if constexpr (GATHER) { PG8_GOFF(vA, cur); }
    PG8_STAGE(PG8_SB(0, 0), cB, voffB); PG8_STAGE(PG8_SB(0, 1), cB + hstep, voffB); PG8_STAGE(PG8_SA(0, 0), cA, vA[0]); PG8_STAGE(PG8_SA(0, 1), cA, vA[1]);
    if (wr == 1) PG8_BAR;
    PG8_WAIT_V(2); PG8_BAR;
    PG8_STAGE(PG8_SB(1, 0), cB + kstep, voffB); PG8_STAGE(PG8_SA(1, 0), cA + kstep, vA[0]); PG8_STAGE(PG8_SB(1, 1), cB + hstep + kstep, voffB);
    PG8_WAIT_V(6); PG8_BAR;
    for (;;) {
        const bool has_next = S.next(ui + 1, nxt);
        const char* nA = has_next ? PG8_APTR(nxt) : cA; const char* nB = has_next ? PG8_BPTR(nxt) : cB;
        if constexpr (GATHER) { if (has_next) { PG8_GOFF(vN, nxt); } else {
#pragma unroll
            for (int h = 0; h < 2; ++h)
#pragma unroll
                for (int i = 0; i < 2; ++i) vN[h][i] = vA[h][i]; } }
        for (int t = 0; t < nt; t += 2) {
            const bool last = (t == nt - 2);
            const char* a1 = cA + (size_t)(t + 1) * kstep;
            const char* a2 = last ? nA : cA + (size_t)(t + 2) * kstep; const char* b2 = last ? nB : cB + (size_t)(t + 2) * kstep;
            const char* a3 = a2 + kstep; const char* b3 = b2 + kstep;
            unsigned v2[2][2];
#pragma unroll
            for (int h = 0; h < 2; ++h)
#pragma unroll
                for (int i = 0; i < 2; ++i) v2[h][i] = (GATHER && last) ? vN[h][i] : vA[h][i];
            PG8_LDB(B0, 0, 0); PG8_LDB(B1, 0, 1); PG8_SCHED; PG8_LDA(At, 0, 0); PG8_STAGE(PG8_SA(1, 1), a1, vA[1]);
            PG8_WAIT_V(8); PG8_WAIT_L(0); PG8_BAR; PG8_MMA(0, 0, At, B0); PG8_MMA(0, 1, At, B1); PG8_BAR; PG8_SCHED;
            PG8_LDA(At, 0, 1); PG8_STAGE(PG8_SB(0, 0), b2, voffB); PG8_STAGE(PG8_SB(0, 1), b2 + hstep, voffB); PG8_STAGE(PG8_SA(0, 0), a2, v2[0]);
            PG8_WAIT_V(8); PG8_WAIT_L(0); PG8_BAR; PG8_MMA(1, 0, At, B0); PG8_MMA(1, 1, At, B1); PG8_BAR; PG8_SCHED;
            PG8_LDB(B0, 1, 0); PG8_LDB(B1, 1, 1); PG8_SCHED; PG8_LDA(At, 1, 0); PG8_STAGE(PG8_SA(0, 1), a2, v2[1]);
            PG8_WAIT_V(8); PG8_WAIT_L(0); PG8_BAR; PG8_MMA(0, 0, At, B0); PG8_MMA(0, 1, At, B1); PG8_BAR; PG8_SCHED;
            PG8_LDA(At, 1, 1); PG8_STAGE(PG8_SB(1, 0), b3, voffB); PG8_STAGE(PG8_SB(1, 1), b3 + hstep, voffB); PG8_STAGE(PG8_SA(1, 0), a3, v2[0]);
            PG8_WAIT_V(8); PG8_WAIT_L(0); PG8_BAR; PG8_MMA(1, 0, At, B0); PG8_MMA(1, 1, At, B1); PG8_BAR; PG8_SCHED;
        }
        if (wr == 0) PG8_BAR;
        E(acc, cur, wr, wc, fr, fq);
        if (!has_next) break;
#pragma unroll
        for (int a = 0; a < 2; ++a)
#pragma unroll
            for (int b = 0; b < 2; ++b)
#pragma unroll
                for (int m = 0; m < 4; ++m)
#pragma unroll
                    for (int n = 0; n < 2; ++n) acc[a][b][m][n] = (f32x4){0.f, 0.f, 0.f, 0.f};
        cur = nxt; cA = nA; cB = nB; ++ui;
#pragma unroll
        for (int h = 0; h < 2; ++h)
#pragma unroll
            for (int i = 0; i < 2; ++i) vA[h][i] = vN[h][i];
        if (wr == 1) PG8_BAR;
    }
    PG8_WAIT_V(0);
    PG8_BAR;
#undef PG8_SA
#undef PG8_SB
#undef PG8_STAGE
#undef PG8_LDA
#undef PG8_LDB
#undef PG8_MMA
#undef PG8_WAIT_V
#undef PG8_WAIT_L
#undef PG8_BAR
#undef PG8_SCHED
#undef PG8_APTR
#undef PG8_BPTR
#undef PG8_GOFF
}
}

namespace att {
constexpr int SLOTB = 8192;
constexpr int NSLOT = 3;
constexpr int L_K = 0, L_V = NSLOT * SLOTB, L_WS = 2 * NSLOT * SLOTB, L_OST = L_WS + NWAVES * 256, L_TAB = L_OST + NWAVES * 4096, L_FLAG = L_TAB + 4096, L_BYTES = L_FLAG + 256;
#define SBAR() __builtin_amdgcn_sched_barrier(0)
#define WAIT_BAR0() asm volatile("s_waitcnt vmcnt(0) lgkmcnt(0)\n\ts_barrier" ::: "memory")
__device__ __forceinline__ int crow(int r, int hi) { return (r & 3) + 8 * (r >> 2) + 4 * hi; }
__device__ __forceinline__ void glds16(const void* gsrc, unsigned lds_dst) { unsigned keep;
    asm volatile("s_mov_b32 %0, m0\n\ts_mov_b32 m0, %2\n\ts_nop 0\n\tglobal_load_lds_dwordx4 %1, off\n\ts_mov_b32 m0, %0" : "=&s"(keep) : "v"(gsrc), "s"(lds_dst) : "memory"); }
__device__ __forceinline__ void qkt(f32x16& p0, f32x16& p1, const LAS char* Kslot, const bf16x8* qr, const f32x16& c0, int r32, int hi) {
    const LAS char* kb = Kslot + hi * 1024 + r32 * 16;
#pragma unroll
    for (int d0 = 0; d0 < 4; ++d0) {
        const bf16x8 b0 = *(const LAS bf16x8*)(kb + d0 * 2048);
        const bf16x8 b1 = *(const LAS bf16x8*)(kb + d0 * 2048 + 512);
        if (d0 == 0) { p0 = __builtin_amdgcn_mfma_f32_32x32x16_bf16(b0, qr[0], c0, 0, 0, 0); p1 = __builtin_amdgcn_mfma_f32_32x32x16_bf16(b1, qr[0], c0, 0, 0, 0); }
        else { p0 = __builtin_amdgcn_mfma_f32_32x32x16_bf16(b0, qr[d0], p0, 0, 0, 0); p1 = __builtin_amdgcn_mfma_f32_32x32x16_bf16(b1, qr[d0], p1, 0, 0, 0); } }
}
__device__ __forceinline__ void pv(f32x16* o, int vb, bf16x8 pa0, bf16x8 pa1, bf16x8 pa2, bf16x8 pa3) {
#pragma unroll
    for (int d0 = 0; d0 < 2; ++d0) { s16x4 lo[4], hi[4];
#pragma unroll
        for (int ks = 0; ks < 4; ++ks) {
            asm volatile("ds_read_b64_tr_b16 %0,%1 offset:%c2" : "=&v"(lo[ks]) : "v"(vb), "i"(d0 * 4096 + ks * 1024) : "memory");
            asm volatile("ds_read_b64_tr_b16 %0,%1 offset:%c2" : "=&v"(hi[ks]) : "v"(vb), "i"(d0 * 4096 + ks * 1024 + 512) : "memory"); }
        asm volatile("s_waitcnt lgkmcnt(0)" ::: "memory"); SBAR();
#define PK(k) (bf16x8){lo[k][0], lo[k][1], lo[k][2], lo[k][3], hi[k][0], hi[k][1], hi[k][2], hi[k][3]}
        o[d0] = __builtin_amdgcn_mfma_f32_32x32x16_bf16(pa0, PK(0), o[d0], 0, 0, 0);
        o[d0] = __builtin_amdgcn_mfma_f32_32x32x16_bf16(pa1, PK(1), o[d0], 0, 0, 0);
        o[d0] = __builtin_amdgcn_mfma_f32_32x32x16_bf16(pa2, PK(2), o[d0], 0, 0, 0);
        o[d0] = __builtin_amdgcn_mfma_f32_32x32x16_bf16(pa3, PK(3), o[d0], 0, 0, 0);
#undef PK
    }
}
__device__ __forceinline__ float swap_sum(float v) { auto rr = __builtin_amdgcn_permlane32_swap(__float_as_uint(v), __float_as_uint(v), false, false); return __uint_as_float(rr[0]) + __uint_as_float(rr[1]); }
__device__ __forceinline__ float swap_max(float v) { auto rr = __builtin_amdgcn_permlane32_swap(__float_as_uint(v), __float_as_uint(v), false, false); return __builtin_fmaxf(__uint_as_float(rr[0]), __uint_as_float(rr[1])); }
__device__ __forceinline__ float swap_other(float v, int hi) { auto rr = __builtin_amdgcn_permlane32_swap(__float_as_uint(v), __float_as_uint(v), false, false); return __uint_as_float(hi ? rr[0] : rr[1]); }

#define PKW(P, B) cvtpk(P[B], P[B + 1])
__device__ __forceinline__ void store_o(const f32x16* o, const float* rli, bf16_t* Ow, LAS char* shm, int wid, int lane, int r32, int hi) {
    LAS bf16_t* stg = (LAS bf16_t*)(shm + L_OST) + wid * 2048;
#pragma unroll
    for (int r = 0; r < 16; ++r) { const int orow = crow(r, hi);
#pragma unroll
        for (int d0 = 0; d0 < 2; ++d0) stg[orow * 64 + d0 * 32 + r32] = (bf16_t)(cvtpk(o[d0][r] * rli[r], 0.f) & 0xffffu); }
    asm volatile("s_waitcnt lgkmcnt(0)" ::: "memory");
#pragma unroll
    for (int i = 0; i < 4; ++i) { const int row = i * 8 + (lane >> 3), ch = lane & 7; const u32x4 v = *(const LAS u32x4*)(stg + row * 64 + ch * 8); *(u32x4*)(Ow + (size_t)row * DM + ch * 8) = v; }
}

__device__ __forceinline__ void sb_half(f32x16& P, float carry_in, float& total, int hi, int t, int s_base) {
    float L[16], lw[16];
#pragma unroll
    for (int r = 0; r < 16; ++r) { const float z = P[r]; const float az = __builtin_fabsf(z);
        const float sp = __builtin_fmaxf(z, 0.f) + __builtin_amdgcn_logf(1.0f + __builtin_amdgcn_exp2f(-az));
        const bool valid = (s_base + crow(r, hi)) < t;
        L[r] = valid ? -sp : 0.f; lw[r] = valid ? (z - sp) : -INFINITY; }
    float G[4], T[4], Gp[4];
#pragma unroll
    for (int g = 0; g < 4; ++g) { G[g] = (L[4 * g] + L[4 * g + 1]) + (L[4 * g + 2] + L[4 * g + 3]);
        auto rr = __builtin_amdgcn_permlane32_swap(__float_as_uint(G[g]), __float_as_uint(G[g]), false, false);
        T[g] = __uint_as_float(rr[0]) + __uint_as_float(rr[1]); Gp[g] = __uint_as_float(hi ? rr[0] : rr[1]); }
    float st = carry_in;
#pragma unroll
    for (int g = 3; g >= 0; --g) {
        float a = st + (hi ? 0.f : Gp[g]);
        P[4 * g + 3] = __builtin_amdgcn_exp2f(lw[4 * g + 3] + a); a += L[4 * g + 3];
        P[4 * g + 2] = __builtin_amdgcn_exp2f(lw[4 * g + 2] + a); a += L[4 * g + 2];
        P[4 * g + 1] = __builtin_amdgcn_exp2f(lw[4 * g + 1] + a); a += L[4 * g + 1];
        P[4 * g + 0] = __builtin_amdgcn_exp2f(lw[4 * g + 0] + a);
        st += T[g]; }
    total = (T[0] + T[1]) + (T[2] + T[3]);
}
__device__ __forceinline__ void sb_unit(int b, int h, int qb, const bf16_t* Q, const bf16_t* K, const bf16_t* V, bf16_t* O, LAS char* shm) {
    int tid = threadIdx.x; asm volatile("" : "+v"(tid));
    const int lane = tid & 63, r32 = lane & 31, hi = lane >> 5; const int wid = __builtin_amdgcn_readfirstlane(tid >> 6);
    const size_t rowbase = (size_t)b * SEQ; const int q0 = qb * 256;
    const bf16_t* Qw = Q + (rowbase + q0 + wid * 32) * DM + h * HD;
    const bf16_t* Kh = K + rowbase * DM + h * HD; const bf16_t* Vh = V + rowbase * DM + h * HD;
    const unsigned lds0 = (unsigned)(uintptr_t)shm;
    const bf16_t* ksrc = Kh + (size_t)lane * DM + wid * 8;
    const bf16_t* vsrc = Vh + (size_t)(16 * (wid & 3) + (lane >> 2)) * DM + (wid >> 2) * 32 + (lane & 3) * 8;
    const unsigned kdst = lds0 + L_K + wid * 1024, vdst = lds0 + L_V + wid * 1024;
    const int vb0 = (int)(lds0 + L_V) + ((lane >> 4) & 1) * 32 + (lane & 3) * 8 + (4 * hi + ((lane & 15) >> 2)) * 64;
    LAS int* flags = (LAS int*)(shm + L_FLAG);
    bf16x8 qr[4];
#pragma unroll
    for (int d0 = 0; d0 < 4; ++d0) qr[d0] = *(const bf16x8*)(Qw + (size_t)r32 * DM + d0 * 16 + hi * 8);
    const int t = q0 + wid * 32 + r32;
    const int jtw = (q0 + wid * 32) >> 6;
    f32x16 o[2]; o[0] = f32x16{}; o[1] = f32x16{};
    float carry = 0.f; bool mydone = false;
    int cur = 4 * qb + 3, slot = 0, it = 0;
    glds16(ksrc + (size_t)cur * 64 * DM, (unsigned)__builtin_amdgcn_readfirstlane(kdst));
    glds16(vsrc + (size_t)cur * 64 * DM, (unsigned)__builtin_amdgcn_readfirstlane(vdst));
    for (;;) {
        WAIT_BAR0();
        if (it > 0) {
            int all = 1;
#pragma unroll
            for (int w = 0; w < NWAVES; ++w) all &= flags[((it - 1) & 1) * NWAVES + w];
            if (__builtin_amdgcn_readfirstlane(all)) break;
        }
        if (cur > 0) { glds16(ksrc + (size_t)(cur - 1) * 64 * DM, (unsigned)__builtin_amdgcn_readfirstlane(kdst + (slot ^ 1) * SLOTB));
                       glds16(vsrc + (size_t)(cur - 1) * 64 * DM, (unsigned)__builtin_amdgcn_readfirstlane(vdst + (slot ^ 1) * SLOTB)); }
        if (cur <= jtw && !mydone) {
            f32x16 p0, p1; const f32x16 zero = f32x16{};
            qkt(p0, p1, shm + L_K + slot * SLOTB, qr, zero, r32, hi);
            float tot1, tot0;
            sb_half(p1, carry, tot1, hi, t, 64 * cur + 32);
            sb_half(p0, carry + tot1, tot0, hi, t, 64 * cur);
            carry += tot1 + tot0;
            u32x4 pw0 = (u32x4){PKW(p0, 0), PKW(p0, 2), PKW(p0, 4), PKW(p0, 6)}, pw1 = (u32x4){PKW(p0, 8), PKW(p0, 10), PKW(p0, 12), PKW(p0, 14)};
            u32x4 pw2 = (u32x4){PKW(p1, 0), PKW(p1, 2), PKW(p1, 4), PKW(p1, 6)}, pw3 = (u32x4){PKW(p1, 8), PKW(p1, 10), PKW(p1, 12), PKW(p1, 14)};
            SBAR();
            pv(o, vb0 + slot * SLOTB, __builtin_bit_cast(bf16x8, pw0), __builtin_bit_cast(bf16x8, pw1), __builtin_bit_cast(bf16x8, pw2), __builtin_bit_cast(bf16x8, pw3));
            mydone = __all(carry < -64.0f);
        }
        if (lane == 0) flags[(it & 1) * NWAVES + wid] = mydone ? 1 : 0;
        if (cur == 0) break;
        --cur; slot ^= 1; ++it;
    }
    float one[16];
#pragma unroll
    for (int r = 0; r < 16; ++r) one[r] = 1.0f;
    store_o(o, one, O + (rowbase + q0 + wid * 32) * DM + h * HD, shm, wid, lane, r32, hi);
    WAIT_BAR0();
}

__device__ const unsigned char T5B[128] = {0, 1, 2, 3, 4, 5, 6, 7, 8, 9, 10, 11, 12, 13, 14, 15, 16, 16, 16, 17, 17, 18, 18, 18, 19, 19, 19, 20, 20, 20, 20, 21, 21, 21, 21, 22, 22, 22, 22, 22, 23, 23, 23, 23, 23, 23,
    24, 24, 24, 24, 24, 24, 25, 25, 25, 25, 25, 25, 25, 26, 26, 26, 26, 26, 26, 26, 26, 27, 27, 27, 27, 27, 27, 27, 27, 27, 27, 28, 28, 28, 28, 28, 28, 28, 28, 28, 28, 29, 29, 29, 29, 29, 29, 29, 29, 29, 29, 29, 29,
    30, 30, 30, 30, 30, 30, 30, 30, 30, 30, 30, 30, 30, 30, 31, 31, 31, 31, 31, 31, 31, 31, 31, 31, 31, 31, 31, 31, 31};
__device__ __forceinline__ void moba_unit(int b, int h, int own, const bf16_t* Q, const bf16_t* K, const bf16_t* V, bf16_t* O, const float* km, const float* rel_bias, LAS char* shm) {
    int tid = threadIdx.x; asm volatile("" : "+v"(tid));
    const int lane = tid & 63, r32 = lane & 31, hi = lane >> 5; const int wid = __builtin_amdgcn_readfirstlane(tid >> 6);
    const size_t rowbase = (size_t)b * SEQ; const int q0 = own * 256;
    const bf16_t* Qw = Q + (rowbase + q0 + wid * 32) * DM + h * HD;
    const bf16_t* Kh = K + rowbase * DM + h * HD; const bf16_t* Vh = V + rowbase * DM + h * HD;
    const unsigned lds0 = (unsigned)(uintptr_t)shm;
    const bf16_t* ksrc = Kh + (size_t)lane * DM + wid * 8;
    const bf16_t* vsrc = Vh + (size_t)(16 * (wid & 3) + (lane >> 2)) * DM + (wid >> 2) * 32 + (lane & 3) * 8;
    const unsigned kdst = lds0 + L_K + wid * 1024, vdst = lds0 + L_V + wid * 1024;
    const int vb0 = (int)(lds0 + L_V) + ((lane >> 4) & 1) * 32 + (lane & 3) * 8 + (4 * hi + ((lane & 15) >> 2)) * 64;
    LAS float* wsf = (LAS float*)(shm + L_WS) + wid * 64;
    LAS float* kmL = (LAS float*)(shm + L_TAB);
    LAS float* dlL = kmL + 512;
    kmL[tid] = km[(size_t)(b * NH + h) * 512 + tid];
    if (tid < 128) dlL[tid] = (rel_bias[(int)T5B[tid] * NH + h] - rel_bias[31 * NH + h]) * LOG2E;
    const int NT = 4 * own + 4;
    glds16(ksrc, (unsigned)__builtin_amdgcn_readfirstlane(kdst));
    glds16(vsrc, (unsigned)__builtin_amdgcn_readfirstlane(vdst));
    bf16x8 qr[4];
#pragma unroll
    for (int d0 = 0; d0 < 4; ++d0) qr[d0] = *(const bf16x8*)(Qw + (size_t)r32 * DM + d0 * 16 + hi * 8);
    WAIT_BAR0();
    unsigned sel = 0;
    {
        float gp[8];
#pragma unroll
        for (int n = 0; n < 8; ++n) gp[n] = 0.f;
#pragma unroll
        for (int d0 = 0; d0 < 4; ++d0)
#pragma unroll
            for (int n = 0; n < 8; ++n) { const LAS f32x4* kp = (const LAS f32x4*)(kmL + n * 64 + d0 * 16 + hi * 8); const f32x4 k0 = kp[0], k1 = kp[1];
                gp[n] += bf2f((unsigned short)qr[d0][0]) * k0[0] + bf2f((unsigned short)qr[d0][1]) * k0[1] + bf2f((unsigned short)qr[d0][2]) * k0[2] + bf2f((unsigned short)qr[d0][3]) * k0[3]
                       + bf2f((unsigned short)qr[d0][4]) * k1[0] + bf2f((unsigned short)qr[d0][5]) * k1[1] + bf2f((unsigned short)qr[d0][6]) * k1[2] + bf2f((unsigned short)qr[d0][7]) * k1[3]; }
        float gt[8];
#pragma unroll
        for (int n = 0; n < 8; ++n) gt[n] = swap_sum(gp[n]);
#pragma unroll
        for (int n = 0; n < 8; ++n) { int rank = 0;
#pragma unroll
            for (int m2 = 0; m2 < 8; ++m2) if (m2 != n) rank += (m2 < own && (gt[m2] > gt[n] || (gt[m2] == gt[n] && m2 < n))) ? 1 : 0;
            if (n < own && rank < 3) sel |= 1u << n; }
    }
    const int t = q0 + wid * 32 + r32;
    f32x16 o[2]; o[0] = f32x16{}; o[1] = f32x16{};
    float m_run = -1e30f, l_run = 0.f;
    for (int tt = 0; tt < NT; ++tt) {
        const int slot = tt & 1;
        if (tt > 0) WAIT_BAR0();
        if (tt + 1 < NT) { glds16(ksrc + (size_t)(tt + 1) * 64 * DM, (unsigned)__builtin_amdgcn_readfirstlane(kdst + (slot ^ 1) * SLOTB));
                           glds16(vsrc + (size_t)(tt + 1) * 64 * DM, (unsigned)__builtin_amdgcn_readfirstlane(vdst + (slot ^ 1) * SLOTB)); }
        const int n = tt >> 2; const bool ownb = (n == own); const int key0 = 64 * tt;
        if (ownb && key0 > q0 + wid * 32 + 31) continue;
        const bool lsel = ownb || ((sel >> n) & 1u);
        f32x16 c0; { const float cv = lsel ? 0.f : -INFINITY;
#pragma unroll
            for (int r = 0; r < 16; ++r) c0[r] = cv; }
        f32x16 p0, p1;
        qkt(p0, p1, shm + L_K + slot * SLOTB, qr, c0, r32, hi);
        if (key0 + 63 + 127 >= q0 + wid * 32) {
#pragma unroll
            for (int r = 0; r < 16; ++r) { const int d0 = t - (key0 + crow(r, hi)), d1 = d0 - 32;
                if (d0 < 0) p0[r] = -INFINITY; else if (d0 < 128) p0[r] += dlL[d0];
                if (d1 < 0) p1[r] = -INFINITY; else if (d1 < 128) p1[r] += dlL[d1]; }
        }
        float mx = p0[0];
#pragma unroll
        for (int r = 1; r < 16; ++r) mx = __builtin_fmaxf(mx, p0[r]);
#pragma unroll
        for (int r = 0; r < 16; ++r) mx = __builtin_fmaxf(mx, p1[r]);
        mx = swap_max(mx);
        const float m_new = __builtin_fmaxf(m_run, mx);
        const float alpha = __builtin_amdgcn_exp2f(m_run - m_new);
        m_run = m_new;
        float ls = 0.f;
#pragma unroll
        for (int r = 0; r < 16; ++r) { p0[r] = __builtin_amdgcn_exp2f(p0[r] - m_new); ls += p0[r]; }
#pragma unroll
        for (int r = 0; r < 16; ++r) { p1[r] = __builtin_amdgcn_exp2f(p1[r] - m_new); ls += p1[r]; }
        l_run = l_run * alpha + ls;
        if (__any(alpha != 1.0f)) {
            if (hi == 0) wsf[r32] = alpha;
            asm volatile("s_waitcnt lgkmcnt(0)" ::: "memory");
#pragma unroll
            for (int r = 0; r < 16; ++r) { const float f = wsf[crow(r, hi)]; o[0][r] *= f; o[1][r] *= f; }
        }
        u32x4 pw0 = (u32x4){PKW(p0, 0), PKW(p0, 2), PKW(p0, 4), PKW(p0, 6)}, pw1 = (u32x4){PKW(p0, 8), PKW(p0, 10), PKW(p0, 12), PKW(p0, 14)};
        u32x4 pw2 = (u32x4){PKW(p1, 0), PKW(p1, 2), PKW(p1, 4), PKW(p1, 6)}, pw3 = (u32x4){PKW(p1, 8), PKW(p1, 10), PKW(p1, 12), PKW(p1, 14)};
        SBAR();
        pv(o, vb0 + slot * SLOTB, __builtin_bit_cast(bf16x8, pw0), __builtin_bit_cast(bf16x8, pw1), __builtin_bit_cast(bf16x8, pw2), __builtin_bit_cast(bf16x8, pw3));
    }
    const float lt = swap_sum(l_run);
    if (hi == 0) wsf[32 + r32] = lt;
    asm volatile("s_waitcnt lgkmcnt(0)" ::: "memory");
    float rli[16];
#pragma unroll
    for (int r = 0; r < 16; ++r) rli[r] = __builtin_amdgcn_rcpf(wsf[32 + crow(r, hi)]);
    store_o(o, rli, O + (rowbase + q0 + wid * 32) * DM + h * HD, shm, wid, lane, r32, hi);
    WAIT_BAR0();
}

#undef PKW
__device__ __forceinline__ float max3f(float a,float b,float c){float r;asm("v_max3_f32 %0, %1, %2, %3":"=v"(r):"v"(a),"v"(b),"v"(c));return r;}
__device__ __forceinline__ float max2f(float a,float b){float r;asm("v_max_f32_e32 %0, %1, %2":"=v"(r):"v"(a),"v"(b));return r;}
__device__ __forceinline__ float fadd_s(float a,float b){float r;asm("v_add_f32_e32 %0, %1, %2":"=v"(r):"v"(a),"v"(b));return r;}
__device__ __forceinline__ float fsub_s(float a,float b){float r;asm("v_sub_f32_e32 %0, %1, %2":"=v"(r):"v"(a),"v"(b));return r;}
#define WAIT_BAR(N) asm volatile("s_waitcnt vmcnt(" #N ") lgkmcnt(0)\n\ts_barrier":::"memory")
typedef LAS const char* lds_cptr;
__device__ __forceinline__ void kload8(bf16x8*kf,lds_cptr kp){
  kf[0]=*(const LAS bf16x8*)(kp);      kf[1]=*(const LAS bf16x8*)(kp+512);
  kf[2]=*(const LAS bf16x8*)(kp+2048); kf[3]=*(const LAS bf16x8*)(kp+2560);
  kf[4]=*(const LAS bf16x8*)(kp+4096); kf[5]=*(const LAS bf16x8*)(kp+4608);
  kf[6]=*(const LAS bf16x8*)(kp+6144); kf[7]=*(const LAS bf16x8*)(kp+6656);
}
__device__ __forceinline__ void kload2(bf16x8*kf,lds_cptr kp,int j){ kf[2*j]=*(const LAS bf16x8*)(kp+j*2048); kf[2*j+1]=*(const LAS bf16x8*)(kp+j*2048+512); }
__device__ __forceinline__ s16x4 vtr(lds_cptr p){ return __builtin_bit_cast(s16x4,__builtin_amdgcn_ds_read_tr16_b64_v4i16((LAS v4i16_t*)p)); }
__device__ __forceinline__ float rowmax(const f32x16&p0,const f32x16&p1){
  float a=max3f(p0[0],p0[1],p1[0]),b=max3f(p0[2],p0[3],p1[1]);a=max3f(a,p1[2],p1[3]);
  #pragma unroll
  for(int r=4;r<16;r+=4){a=max3f(a,p0[r],p0[r+1]);b=max3f(b,p0[r+2],p0[r+3]);a=max3f(a,p1[r],p1[r+1]);b=max3f(b,p1[r+2],p1[r+3]);}
  const float m=max2f(a,b);
  auto rr=__builtin_amdgcn_permlane32_swap(__float_as_uint(m),__float_as_uint(m),false,false);
  return max2f(__uint_as_float(rr[0]),__uint_as_float(rr[1]));
}
__device__ __forceinline__ void bmask(f32x16&p0,f32x16&p1,int tile,int tq,int hi,const LAS float*dl){
  const int kb=64*tile+4*hi;
  #pragma unroll
  for(int r=0;r<16;++r){ const int d0=tq-(kb+(r&3)+8*(r>>2)), d1=d0-32;
    if(d0<0)p0[r]=-INFINITY; else if(d0<128)p0[r]+=dl[d0];
    if(d1<0)p1[r]=-INFINITY; else if(d1<128)p1[r]+=dl[d1]; }
}
template<int THRL> __device__ __forceinline__ void moba_fast(int b,int h,int qb,const bf16_t*Q,const bf16_t*__restrict__ K,const bf16_t*__restrict__ V,bf16_t*O,const float*km,const float*rel_bias,LAS char*shm){
  int tid=threadIdx.x; asm volatile("":"+v"(tid));
  const int lane=tid&63,r32=lane&31,hi=lane>>5; const int wid=__builtin_amdgcn_readfirstlane(tid>>6);
  const int own=qb;
  LAS float*kmL=(LAS float*)(shm+L_TAB); LAS float*dlL=kmL+512;
  { const float kv_=km[(size_t)(b*NH+h)*512+tid]; float dv_=0.f; if(tid<128)dv_=(rel_bias[(int)T5B[tid]*NH+h]-rel_bias[31*NH+h])*LOG2E; kmL[tid]=kv_; if(tid<128)dlL[tid]=dv_; }
  const long rowbase=(long)b*SEQ; const int q0=qb*256;
  const bf16_t*Qw=Q+(rowbase+q0+wid*32)*DM+h*HD;
  const bf16_t*Kh=K+rowbase*DM+h*HD,*Vh=V+rowbase*DM+h*HD;
  const unsigned lds0=(unsigned)(uintptr_t)shm;
  LAS float*wsf=(LAS float*)(shm+L_WS)+wid*64;
  const bf16_t*ksrc=Kh+(long)lane*DM+wid*8;
  const bf16_t*vsrc=Vh+(long)(16*(wid&3)+(lane>>2))*DM+(wid>>2)*32+(lane&3)*8;
  const unsigned kdst=lds0+L_K+wid*1024, vdst=lds0+L_V+wid*1024;
  #define DMA_K(t,slot) glds16(ksrc+(long)(t)*64*DM,(unsigned)__builtin_amdgcn_readfirstlane(kdst+(slot)))
  #define DMA_V(t,slot) glds16(vsrc+(long)(t)*64*DM,(unsigned)__builtin_amdgcn_readfirstlane(vdst+(slot)))
  const int vb0=(int)(lds0+L_V)+((lane>>4)&1)*32+(lane&3)*8+(4*hi+((lane&15)>>2))*64;
  const LAS char*Kbase=shm+L_K; bf16x8 kf[8];
  const lds_cptr shm3=(lds_cptr)shm; const lds_cptr kp0=shm3+L_K+hi*1024+r32*16; const lds_cptr vp0=shm3+L_V+((lane>>4)&1)*32+(lane&3)*8+(4*hi+((lane&15)>>2))*64;
  const int NT=(q0+256)/64;
  DMA_K(0,0);DMA_V(0,0);DMA_K(1,SLOTB);
  bf16x8 qr[4];
  #pragma unroll
  for(int d0=0;d0<4;++d0)qr[d0]=*reinterpret_cast<const bf16x8*>(&Qw[(long)r32*DM+d0*16+hi*8]);
  const int tq=q0+wid*32+r32;
  float mhat=0.f,l_reg=0.f,negsel=0.f;f32x16 o[2];o[0]=f32x16{};o[1]=f32x16{};f32x16 negm=f32x16{};asm volatile("":"+v"(negm));
  unsigned sel=0u; bool seen=false;
  #define SETSEL(n) do{ negsel=((n)==own||((sel>>(n))&1u))?0.f:-1e30f; const float nm_=negsel-mhat; _Pragma("unroll") for(int r=0;r<16;++r)negm[r]=nm_; asm volatile("":"+v"(negm)); }while(0)
  #define CMASK(P0,P1,t) do{ if(64*(t)+63+127>=q0+wid*32) bmask(P0,P1,(t),tq,hi,dlL); }while(0)
  bool resc=false;
  #define START(P0,P1) do{ const float rm=rowmax(P0,P1); resc=false; seen=rm>-1e29f; \
    { const float dl=seen?rm:0.f; mhat=fadd_s(mhat,dl); \
      _Pragma("unroll") for(int r=0;r<16;++r){P0[r]=fsub_s(P0[r],dl);P1[r]=fsub_s(P1[r],dl);} \
      { const float nm_=negsel-mhat; _Pragma("unroll") for(int r=0;r<16;++r)negm[r]=nm_; } asm volatile("":"+v"(negm)); } \
    _Pragma("unroll") for(int r=0;r<16;++r)P0[r]=__builtin_amdgcn_exp2f(P0[r]); }while(0)
  #define RESC() do{ if(resc){ asm volatile("s_waitcnt lgkmcnt(0)":::"memory"); \
      _Pragma("unroll") for(int d_=0;d_<2;++d_) _Pragma("unroll") for(int r=0;r<16;++r)o[d_][r]*=wsf[crow(r,hi)]; } }while(0)
  f32x16 pA0,pA1,pB0,pB1;
  int sl_prev=0,sl_cur=0,sl_next=SLOTB;
  #define ROT() do{sl_prev=sl_cur;sl_cur=sl_next;sl_next=(sl_next==(NSLOT-1)*SLOTB)?0:sl_next+SLOTB;}while(0)
  DMA_K(2,2*SLOTB);
  WAIT_BAR(3);
  { float gp[8];
    #pragma unroll
    for(int n=0;n<8;++n)gp[n]=0.f;
    #pragma unroll
    for(int d0=0;d0<4;++d0){
      #pragma unroll
      for(int n=0;n<8;++n){ const LAS f32x4*kp=(const LAS f32x4*)(kmL+n*64+d0*16+hi*8); const f32x4 k0=kp[0],k1=kp[1];
        gp[n]+=bf2f((unsigned short)qr[d0][0])*k0[0]+bf2f((unsigned short)qr[d0][1])*k0[1]+bf2f((unsigned short)qr[d0][2])*k0[2]+bf2f((unsigned short)qr[d0][3])*k0[3]
              +bf2f((unsigned short)qr[d0][4])*k1[0]+bf2f((unsigned short)qr[d0][5])*k1[1]+bf2f((unsigned short)qr[d0][6])*k1[2]+bf2f((unsigned short)qr[d0][7])*k1[3]; } }
    float gt[8];
    #pragma unroll
    for(int n=0;n<8;++n)gt[n]=swap_sum(gp[n]);
    #pragma unroll
    for(int n=0;n<8;++n){ int rank=0;
      #pragma unroll
      for(int m2=0;m2<8;++m2) if(m2!=n) rank+=(m2<own&&(gt[m2]>gt[n]||(gt[m2]==gt[n]&&m2<n)))?1:0;
      if(n<own&&rank<3)sel|=1u<<n; } }
  SETSEL(0);
  qkt(pA0,pA1,Kbase,qr,negm,r32,hi);asm volatile("s_nop 15\n\ts_nop 7":"+v"(pA0),"+v"(pA1));CMASK(pA0,pA1,0);
  START(pA0,pA1);
  _Pragma("unroll") for(int r=0;r<16;++r)pA1[r]=__builtin_amdgcn_exp2f(pA1[r]);
  WAIT_BAR(0);
  DMA_K(3,0);DMA_V(1,SLOTB);
  ROT();
  kload8(kf,kp0+sl_cur);
  WAIT_BAR(2);
  s16x4 vlo[8],vhi[8]; u32x4 pw0,pw1,pw2,pw3;
  #define PKW(P,B) cvtpk(P[B],P[B+1])
  #define PAF(k) __builtin_bit_cast(bf16x8,pw##k)
  #define VFR(i) (bf16x8){vlo[i][0],vlo[i][1],vlo[i][2],vlo[i][3],vhi[i][0],vhi[i][1],vhi[i][2],vhi[i][3]}
  #define PIN(x) asm volatile("":"+v"(x))
  #define MX3(a,b,c) __builtin_fmaxf(__builtin_fmaxf((a),(b)),(c))
  #define GAPA(MF,A0,A1,A2,A3,W0,W1,PW) do{ MF; sacc+=A0; sacc+=A1; sacc+=A2; sacc+=A3; PIN(sacc); W0; W1; PIN(PW); SBAR(); }while(0)
  #define EX(v) __builtin_amdgcn_exp2f(v)
  #define GAPB(MF,X,B) do{ MF; X[B]=EX(X[B]); X[B+1]=EX(X[B+1]); X[B+2]=EX(X[B+2]); X[B+3]=EX(X[B+3]); PIN(X); SBAR(); }while(0)
  #define VRD(i) do{ vlo[i]=vtr(vp_+(((i)>>2)*4096+((i)&3)*1024)); vhi[i]=vtr(vp_+(((i)>>2)*4096+((i)&3)*1024+512)); }while(0)
  #define KRD(G,j) do{ if(G){ kload2(kf,kp0+sl_next,j); SBAR(); } }while(0)
  #define STEP(C0,C1,P0,P1,t,GK,GV,GL) do{ SBAR(); \
    const lds_cptr vp_=vp0+sl_prev; \
    VRD(0); SBAR(); float sacc=(P0[0]+P0[1]); \
    GAPA(C0=__builtin_amdgcn_mfma_f32_32x32x16_bf16(kf[0],qr[0],negm,0,0,0), P0[2],P0[3],P0[4],P0[5],     pw0[0]=PKW(P0,0), pw0[1]=PKW(P0,2), pw0); \
    VRD(4); SBAR(); GAPA(C1=__builtin_amdgcn_mfma_f32_32x32x16_bf16(kf[1],qr[0],negm,0,0,0), P0[6],P0[7],P0[8],P0[9],     pw0[2]=PKW(P0,4), pw0[3]=PKW(P0,6), pw0); \
    VRD(1); SBAR(); GAPA(C0=__builtin_amdgcn_mfma_f32_32x32x16_bf16(kf[2],qr[1],C0,0,0,0),   P0[10],P0[11],P0[12],P0[13], pw1[0]=PKW(P0,8), pw1[1]=PKW(P0,10), pw1); \
    VRD(5); SBAR(); GAPA(C1=__builtin_amdgcn_mfma_f32_32x32x16_bf16(kf[3],qr[1],C1,0,0,0),   P0[14],P0[15],P1[0],P1[1],   pw1[2]=PKW(P0,12),pw1[3]=PKW(P0,14), pw1); \
    VRD(2); SBAR(); GAPA(C0=__builtin_amdgcn_mfma_f32_32x32x16_bf16(kf[4],qr[2],C0,0,0,0),   P1[2],P1[3],P1[4],P1[5],     pw2[0]=PKW(P1,0), pw2[1]=PKW(P1,2), pw2); \
    VRD(6); SBAR(); GAPA(C1=__builtin_amdgcn_mfma_f32_32x32x16_bf16(kf[5],qr[2],C1,0,0,0),   P1[6],P1[7],P1[8],P1[9],     pw2[2]=PKW(P1,4), pw2[3]=PKW(P1,6), pw2); \
    VRD(3); SBAR(); GAPA(C0=__builtin_amdgcn_mfma_f32_32x32x16_bf16(kf[6],qr[3],C0,0,0,0),   P1[10],P1[11],P1[12],P1[13], pw3[0]=PKW(P1,8), pw3[1]=PKW(P1,10), pw3); \
    VRD(7); SBAR(); GAPA(C1=__builtin_amdgcn_mfma_f32_32x32x16_bf16(kf[7],qr[3],C1,0,0,0),   P1[14],P1[15],0.f,0.f,       pw3[2]=PKW(P1,12),pw3[3]=PKW(P1,14), pw3); \
    l_reg+=sacc; \
    if(GK){DMA_K((t)+3,sl_cur);} if(GV){DMA_V((t)+1,sl_next);} \
    CMASK(C0,C1,t); \
    { float a=MX3(C0[0],C0[1],C1[0]),b=MX3(C0[2],C0[3],C1[1]); a=MX3(a,C1[2],C1[3]); \
      _Pragma("unroll") for(int r=4;r<16;r+=4){a=MX3(a,C0[r],C0[r+1]);b=MX3(b,C0[r+2],C0[r+3]);a=MX3(a,C1[r],C1[r+1]);b=MX3(b,C1[r+2],C1[r+3]);} \
      float rm=__builtin_fmaxf(a,b); { auto rr=__builtin_amdgcn_permlane32_swap(__float_as_uint(rm),__float_as_uint(rm),false,false); rm=__builtin_fmaxf(__uint_as_float(rr[0]),__uint_as_float(rr[1])); } \
      resc=false; const bool real_=rm>-1e29f; const bool fst_=(!seen)&&real_&&(rm<-(float)THRL); \
      if(__builtin_expect(__any(rm>(float)THRL||fst_),0)){ const float dl=fst_?rm:__builtin_fmaxf(rm,0.f); mhat+=dl; \
        _Pragma("unroll") for(int r=0;r<16;++r){C0[r]-=dl;C1[r]-=dl;} \
        { const float nm_=negsel-mhat; _Pragma("unroll") for(int r=0;r<16;++r)negm[r]=nm_; } asm volatile("":"+v"(negm)); \
        const float f=seen?__builtin_amdgcn_exp2f(-dl):1.f; l_reg*=f; if(hi==0)wsf[r32]=f; resc=true; } seen=seen||real_; } \
    SBAR(); \
    GAPB(o[0]=__builtin_amdgcn_mfma_f32_32x32x16_bf16(PAF(0),VFR(0),o[0],0,0,0), C0,0); \
    GAPB(o[1]=__builtin_amdgcn_mfma_f32_32x32x16_bf16(PAF(0),VFR(4),o[1],0,0,0), C0,4); \
    KRD(GL,0); GAPB(o[0]=__builtin_amdgcn_mfma_f32_32x32x16_bf16(PAF(1),VFR(1),o[0],0,0,0), C0,8); \
    KRD(GL,1); GAPB(o[1]=__builtin_amdgcn_mfma_f32_32x32x16_bf16(PAF(1),VFR(5),o[1],0,0,0), C0,12); \
    KRD(GL,2); GAPB(o[0]=__builtin_amdgcn_mfma_f32_32x32x16_bf16(PAF(2),VFR(2),o[0],0,0,0), C1,0); \
    KRD(GL,3); GAPB(o[1]=__builtin_amdgcn_mfma_f32_32x32x16_bf16(PAF(2),VFR(6),o[1],0,0,0), C1,4); \
    GAPB(o[0]=__builtin_amdgcn_mfma_f32_32x32x16_bf16(PAF(3),VFR(3),o[0],0,0,0), C1,8); \
    GAPB(o[1]=__builtin_amdgcn_mfma_f32_32x32x16_bf16(PAF(3),VFR(7),o[1],0,0,0), C1,12); \
    }while(0)
  int t=1;
  #undef CMASK
  #define CMASK(P0,P1,t) do{}while(0)
  for(;t+7<NT;t+=2){
    STEP(pB0,pB1,pA0,pA1,t,true,true,true);     WAIT_BAR(2); RESC(); ROT();
    if(((t+1)&3)==0)SETSEL((t+1)>>2);
    STEP(pA0,pA1,pB0,pB1,t+1,true,true,true);   WAIT_BAR(2); RESC(); ROT();
  }
  #undef CMASK
  #define CMASK(P0,P1,t) do{ if(64*(t)+63+127>=q0+wid*32) bmask(P0,P1,(t),tq,hi,dlL); }while(0)
  #define ENDW(tt) do{ if((tt)+3<NT){WAIT_BAR(2);} else if((tt)+2<NT){WAIT_BAR(1);} else {WAIT_BAR(0);} }while(0)
  for(;t+1<NT;t+=2){
    STEP(pB0,pB1,pA0,pA1,t,(t+3<NT),(t+1<NT),(t+1<NT));       ENDW(t);   RESC(); ROT();
    if(((t+1)&3)==0)SETSEL((t+1)>>2);
    STEP(pA0,pA1,pB0,pB1,t+1,(t+4<NT),(t+2<NT),(t+2<NT));     ENDW(t+1); RESC(); ROT();
  }
  STEP(pB0,pB1,pA0,pA1,NT-1,false,false,false); RESC();
  { float sacc=pB0[0]+pB0[1]; _Pragma("unroll") for(int r=2;r<16;++r)sacc+=pB0[r]; _Pragma("unroll") for(int r=0;r<16;++r)sacc+=pB1[r]; l_reg+=sacc;
    pw0=(u32x4){PKW(pB0,0),PKW(pB0,2),PKW(pB0,4),PKW(pB0,6)};pw1=(u32x4){PKW(pB0,8),PKW(pB0,10),PKW(pB0,12),PKW(pB0,14)};pw2=(u32x4){PKW(pB1,0),PKW(pB1,2),PKW(pB1,4),PKW(pB1,6)};pw3=(u32x4){PKW(pB1,8),PKW(pB1,10),PKW(pB1,12),PKW(pB1,14)};
    SBAR(); pv(o,vb0+sl_cur,PAF(0),PAF(1),PAF(2),PAF(3)); }
  #undef PKW
  #undef PAF
  #undef VFR
  #undef PIN
  #undef MX3
  #undef GAPA
  #undef GAPB
  #undef EX
  #undef VRD
  #undef KRD
  #undef STEP
  #undef ENDW
  {auto rr=__builtin_amdgcn_permlane32_swap(__float_as_uint(l_reg),__float_as_uint(l_reg),false,false);l_reg=__uint_as_float(rr[0])+__uint_as_float(rr[1]);}
  if(hi==0)wsf[32+r32]=l_reg;asm volatile("s_waitcnt lgkmcnt(0)":::"memory");
  float rli[16];
  #pragma unroll
  for(int r=0;r<16;++r)rli[r]=__builtin_amdgcn_rcpf(wsf[32+crow(r,hi)]);
  bf16_t*Ow=O+(rowbase+q0+wid*32)*DM+h*HD;
  { LAS bf16_t*stg=(LAS bf16_t*)(shm+L_OST)+wid*2048;
    #pragma unroll
    for(int r=0;r<16;++r){const int orow=crow(r,hi);
      #pragma unroll
      for(int d0=0;d0<2;++d0)stg[orow*64+d0*32+r32]=(bf16_t)(cvtpk(o[d0][r]*rli[r],0.f)&0xffffu);}
    asm volatile("s_waitcnt lgkmcnt(0)":::"memory");
    #pragma unroll
    for(int i=0;i<4;++i){const int row=i*8+(lane>>3),ch=lane&7; const u32x4 v=*(const LAS u32x4*)(stg+row*64+ch*8); *(u32x4*)(Ow+(long)row*DM+ch*8)=v;} }
  asm volatile("s_waitcnt lgkmcnt(0)\n\ts_barrier":::"memory");
  #undef DMA_K
  #undef DMA_V
  #undef CMASK
  #undef START
  #undef RESC
  #undef ROT
  #undef SETSEL
}
#undef WAIT_BAR
#undef SBAR
#undef WAIT_BAR0
}

constexpr size_t MiB = 1u << 20, KiB = 1u << 10;
constexpr size_t WS_CTL = 0, CTL_ZERO_BYTES = 1 * MiB;
constexpr size_t WS_SSP = 1 * MiB;
constexpr size_t WS_TAB = 2 * MiB;
constexpr size_t WS_TOKE = WS_TAB, WS_TOKG = WS_TAB + 128 * KiB, WS_TOKS = WS_TAB + 256 * KiB, WS_RSTD = WS_TAB + 384 * KiB;
constexpr size_t WS_ROWIDX = WS_TAB + 448 * KiB, WS_RSLOT = WS_TAB + 592 * KiB;
constexpr size_t WS_HIST = WS_TAB + 736 * KiB, WS_TILEE = WS_TAB + 744 * KiB, WS_NTIL = WS_TAB + 745 * KiB, WS_KM = WS_TAB + 768 * KiB;
constexpr size_t WS_E13 = 4 * MiB, WS_E2 = 116 * MiB, WS_HB = 172 * MiB, WS_SW = 204 * MiB;
constexpr size_t WS_WQKV0 = WS_SW, WS_WQKV1 = WS_SW + 6 * MiB, WS_WO0 = WS_SW + 12 * MiB, WS_WO1 = WS_SW + 14 * MiB, WS_W13 = WS_SW + 16 * MiB, WS_W2 = WS_SW + 27 * MiB;
constexpr size_t WS_QO = 237 * MiB, WS_K = 269 * MiB, WS_V = 301 * MiB, WS_HID0 = 237 * MiB;
constexpr size_t WS_H = 204 * MiB;
constexpr size_t WS_Y = 4 * MiB;
constexpr size_t WS_END = 441 * MiB;
static_assert(MAXSLOT * 4 <= 144 * KiB && WS_KM + 128 * 8 * 64 * 4 <= WS_E13, "tables");
static_assert(WS_W2 + (size_t)DM * FF * 2 <= WS_QO && WS_W13 + (size_t)2 * FF * DM * 2 <= WS_W2, "small weights");
static_assert(WS_HID0 + (size_t)M * FF * 2 <= WS_END && WS_H + (size_t)MAXSLOT * FE * 2 <= WS_END && WS_Y + (size_t)MAXSLOT * DM * 2 <= WS_E2, "overlays");
static_assert(WS_E13 + (size_t)NE * 2 * FE * DM * 2 <= WS_E2 && WS_E2 + (size_t)NE * DM * FE * 2 <= WS_HB && WS_HB + (size_t)M * DM * 2 <= WS_SW, "expert weights");
constexpr int CW_TMO = 0, CW_CODE = 1, CW_BAR = 4096;

constexpr int RING_OFF = 0, RING_BYTES = 131072;
constexpr int LDSCTL_OFF = RING_BYTES, MISC_OFF = LDSCTL_OFF + 320;
constexpr int LDS_BYTES = 147456;
static_assert(att::L_BYTES <= RING_BYTES && MISC_OFF + 128 <= LDS_BYTES, "LDS map");

#define XB_TMO      128
#define XB_XCNT(j)  (256  + 64 * (j))
#define XB_XSUB(j)  (1280 + 64 * (j))
#define XB_XGEN(j)  (2304 + 64 * (j))
#define XB_TOP      3328
#define XB_TOPGEN   3392
#define XCD_BAR_WORDS 3456
#define XB_SPIN_CAP (1u << 18)
__device__ __forceinline__ unsigned xb_ld(unsigned* p)              { return __hip_atomic_load(p, __ATOMIC_RELAXED, __HIP_MEMORY_SCOPE_AGENT); }
__device__ __forceinline__ unsigned xb_add(unsigned* p, unsigned v) { return __hip_atomic_fetch_add(p, v, __ATOMIC_RELAXED, __HIP_MEMORY_SCOPE_AGENT); }
__device__ __forceinline__ unsigned xb_xcc_id() { return (unsigned)__builtin_amdgcn_s_getreg((3 << 11) | 20) & 0xFu; }
#define XB_SPIN(cond, bar) do { unsigned _sp = 0; while (cond) { __builtin_amdgcn_s_sleep(1); \
    if ((++_sp & 255u) == 0u) { if (xb_ld(&(bar)[XB_TMO])) break; if (_sp > XB_SPIN_CAP) { atomicAdd(&(bar)[XB_TMO], 1u); break; } } } } while (0)
struct XcdBarrier { unsigned* bar; unsigned x; volatile LAS unsigned* st; };
__device__ __forceinline__ XcdBarrier xcd_barrier_post(unsigned* bar, volatile LAS unsigned* st) {
    XcdBarrier b; b.bar = bar; b.x = xb_xcc_id(); b.st = st;
    if (threadIdx.x == 0) (void)xb_add(&bar[XB_XCNT(b.x)], 1u);
    return b;
}
__device__ __forceinline__ void xcd_barrier_complete(unsigned* bar, unsigned x, unsigned& nloc, unsigned& nx) {
    const unsigned G = gridDim.x * gridDim.y * gridDim.z;
    unsigned sum, cnt, mine, sp = 0u;
    for (;;) {
        sum = 0u; cnt = 0u; mine = 0u;
#pragma unroll
        for (unsigned j = 0; j < 16; ++j) { const unsigned c = xb_ld(&bar[XB_XCNT(j)]); sum += c; cnt += (c > 0u) ? 1u : 0u; mine = (j == x) ? c : mine; }
        if (sum == G) break;
        __builtin_amdgcn_s_sleep(1);
        if ((++sp & 255u) == 0u) { if (xb_ld(&bar[XB_TMO])) break; if (sp > XB_SPIN_CAP) { atomicAdd(&bar[XB_TMO], 1u); break; } }
    }
    nloc = mine > 0u ? mine : 1u; nx = cnt > 0u ? cnt : 1u;
}
__device__ __forceinline__ void xcd_barrier(const XcdBarrier& b) {
    asm volatile("s_waitcnt vmcnt(0)" ::: "memory");
    __syncthreads();
    if (threadIdx.x == 0) {
        unsigned* bar = b.bar;
        __builtin_amdgcn_s_waitcnt(0);
        unsigned nloc = b.st[0], nx = b.st[1];
        if (nloc == 0u) { xcd_barrier_complete(bar, b.x, nloc, nx); b.st[0] = nloc; b.st[1] = nx; }
        const unsigned old = xb_add(&bar[XB_XSUB(b.x)], 1u);
        const unsigned gen = old / nloc;
        if (old + 1u == (gen + 1u) * nloc) {
            __builtin_amdgcn_fence(__ATOMIC_RELEASE, "agent");
            asm volatile("s_waitcnt vmcnt(0)" ::: "memory");
            const unsigned og = xb_add(&bar[XB_TOP], 1u);
            const unsigned tg = og / nx;
            if (og + 1u == (tg + 1u) * nx) xb_add(&bar[XB_TOPGEN], 1u);
            else XB_SPIN(xb_ld(&bar[XB_TOPGEN]) == tg, bar);
            __builtin_amdgcn_fence(__ATOMIC_ACQUIRE, "agent");
            xb_add(&bar[XB_XGEN(b.x)], 1u);
            asm volatile("s_waitcnt vmcnt(0)" ::: "memory");
        } else {
            XB_SPIN(xb_ld(&bar[XB_XGEN(b.x)]) == gen, bar);
            __builtin_amdgcn_fence(__ATOMIC_ACQUIRE, "agent");
            asm volatile("s_waitcnt vmcnt(0)" ::: "memory");
        }
    }
    __syncthreads();
}

struct Args { const float* in[14]; float* out; unsigned char* ws; };
struct Frame { LAS unsigned char* lds; int tid, lane, wave, vcu, G; };

__device__ __forceinline__ void cvt_item(const float* W, int K, int N, const float* g, bf16_t* WT, int mode, int item, int lane) {
    const int nblk = N / 32, kb = item / nblk, nb = item - kb * nblk, k0 = 64 * kb, n0 = 32 * nb;
    const int nq = lane & 7, ko = lane >> 3;
    const float* src = W + (size_t)(k0 + 8 * ko) * N + n0 + 4 * nq;
    f32x4 v[8];
#pragma unroll
    for (int jj = 0; jj < 8; ++jj) v[jj] = __builtin_nontemporal_load((const f32x4*)(src + (size_t)jj * N));
    if (g) { const f32x4 g0 = *(const f32x4*)(g + k0 + 8 * ko), g1 = *(const f32x4*)(g + k0 + 8 * ko + 4);
#pragma unroll
        for (int jj = 0; jj < 4; ++jj) { v[jj] = v[jj] * g0[jj]; v[4 + jj] = v[4 + jj] * g1[jj]; } }
#pragma unroll
    for (int i = 0; i < 4; ++i) { const int n = n0 + 4 * nq + i; const int row = mode == 0 ? n : (256 * (n >> 7) + (n & 127) + (mode == 2 ? 128 : 0));
        u32x4 o; o.x = cvtpk(v[0][i], v[1][i]); o.y = cvtpk(v[2][i], v[3][i]); o.z = cvtpk(v[4][i], v[5][i]); o.w = cvtpk(v[6][i], v[7][i]);
        *(u32x4*)(WT + (size_t)row * K + k0 + 8 * ko) = o; }
}
__device__ __forceinline__ void p0_prologue(const Frame& F, const Args& a) {
    unsigned char* ws = a.ws;
    const float* w_qkv = a.in[1]; const float* w_o = a.in[2]; const float* mixer_norm = a.in[3]; const float* ffn_norm = a.in[4];
    const float* w1 = a.in[6]; const float* w3 = a.in[7]; const float* w2 = a.in[8]; const float* e_w1 = a.in[10]; const float* e_w3 = a.in[11]; const float* e_w2 = a.in[12];
    const int gw = F.vcu * NWAVES + F.wave, NGW = F.G * NWAVES;
    constexpr int I_QKV = 16 * 96, I_O = 16 * 32, I_13 = 16 * 88, I_2 = 44 * 32, I_E13 = 16 * 112, I_E2 = 56 * 32;
    constexpr int NITEMS = 2 * I_QKV + 2 * I_O + 2 * I_13 + I_2 + 16 * I_E13 + 8 * I_E2;
    for (int it = gw; it < NITEMS; it += NGW) {
        int r = it;
        if (r < 2 * I_QKV) { const int l = r / I_QKV; r -= l * I_QKV; cvt_item(w_qkv + (size_t)l * DM * NQKV, DM, NQKV, mixer_norm + l * DM, (bf16_t*)(ws + (l ? WS_WQKV1 : WS_WQKV0)), 0, r, F.lane); continue; } r -= 2 * I_QKV;
        if (r < 2 * I_O) { const int l = r / I_O; r -= l * I_O; cvt_item(w_o + (size_t)l * DM * DM, DM, DM, nullptr, (bf16_t*)(ws + (l ? WS_WO1 : WS_WO0)), 0, r, F.lane); continue; } r -= 2 * I_O;
        if (r < I_13) { cvt_item(w1, DM, FF, ffn_norm, (bf16_t*)(ws + WS_W13), 1, r, F.lane); continue; } r -= I_13;
        if (r < I_13) { cvt_item(w3, DM, FF, ffn_norm, (bf16_t*)(ws + WS_W13), 2, r, F.lane); continue; } r -= I_13;
        if (r < I_2) { cvt_item(w2, FF, DM, nullptr, (bf16_t*)(ws + WS_W2), 0, r, F.lane); continue; } r -= I_2;
        if (r < 8 * I_E13) { const int e = r / I_E13; r -= e * I_E13; cvt_item(e_w1 + (size_t)e * DM * FE, DM, FE, ffn_norm + DM, (bf16_t*)(ws + WS_E13) + (size_t)e * 2 * FE * DM, 1, r, F.lane); continue; } r -= 8 * I_E13;
        if (r < 8 * I_E13) { const int e = r / I_E13; r -= e * I_E13; cvt_item(e_w3 + (size_t)e * DM * FE, DM, FE, ffn_norm + DM, (bf16_t*)(ws + WS_E13) + (size_t)e * 2 * FE * DM, 2, r, F.lane); continue; } r -= 8 * I_E13;
        { const int e = r / I_E2; r -= e * I_E2; cvt_item(e_w2 + (size_t)e * FE * DM, FE, DM, nullptr, (bf16_t*)(ws + WS_E2) + (size_t)e * DM * FE, 0, r, F.lane); }
    }
    const float* x = a.in[0]; bf16_t* HB = (bf16_t*)(ws + WS_HB); float* ssp = (float*)(ws + WS_SSP);
    for (int m = gw; m < M; m += NGW) {
        const f32x4* xr = (const f32x4*)(x + (size_t)m * DM) + F.lane; f32x4 v[4]; float s = 0.f;
#pragma unroll
        for (int j = 0; j < 4; ++j) { v[j] = xr[64 * j]; s += (v[j][0] * v[j][0] + v[j][1] * v[j][1]) + (v[j][2] * v[j][2] + v[j][3] * v[j][3]); }
        s = wave_sum(s);
        u32x2* o8 = (u32x2*)(HB + (size_t)m * DM) + F.lane;
#pragma unroll
        for (int j = 0; j < 4; ++j) { u32x2 w; w.x = cvtpk(v[j][0], v[j][1]); w.y = cvtpk(v[j][2], v[j][3]); o8[64 * j] = w; }
        if (F.lane < 16) ssp[(size_t)m * 16 + F.lane] = F.lane == 0 ? s : 0.f;
    }
}
__device__ __forceinline__ void kmean_phase(const Frame& F, const bf16_t* Kb, float* km) {
    const int gw = F.vcu * NWAVES + F.wave, NGW = F.G * NWAVES;
    for (int it = gw; it < NB * NH * 8; it += NGW) {
        const int n = it & 7, bh = it >> 3, b = bh >> 4, h = bh & 15;
        const bf16_t* src = Kb + ((size_t)b * SEQ + 256 * n + (F.lane >> 3)) * DM + h * HD + (F.lane & 7) * 8;
        float s[8];
#pragma unroll
        for (int j = 0; j < 8; ++j) s[j] = 0.f;
#pragma unroll 8
        for (int p = 0; p < 32; ++p) { const bf16x8 v = *(const bf16x8*)(src + (size_t)p * 8 * DM);
#pragma unroll
            for (int j = 0; j < 8; ++j) s[j] += bf2f((unsigned short)v[j]); }
#pragma unroll
        for (int j = 0; j < 8; ++j) { s[j] += __shfl_xor(s[j], 8); s[j] += __shfl_xor(s[j], 16); s[j] += __shfl_xor(s[j], 32); }
        if (F.lane < 8) { float* o = km + (size_t)it * 64 + F.lane * 8;
#pragma unroll
            for (int j = 0; j < 8; ++j) o[j] = s[j] * (1.0f / 256.0f); }
    }
}
__device__ __forceinline__ void router_phase(const Frame& F, const Args& a) {
    unsigned char* ws = a.ws; const float* hres = a.out; const float* router = a.in[9]; const float* g = a.in[4] + DM;
    LAS float* rw = (LAS float*)(F.lds);
    LAS int* cnt = (LAS int*)(F.lds + 32768);
    for (int i = F.tid; i < DM * NE; i += NWAVES * 64) rw[i] = router[i] * g[i >> 3];
    if (F.tid < NE) cnt[F.tid] = 0;
    __syncthreads();
    int* tok_e = (int*)(ws + WS_TOKE); float* tok_g = (float*)(ws + WS_TOKG); float* rstd_t = (float*)(ws + WS_RSTD);
    const int c = blockIdx.x;
    for (int i = 0; i < 8; ++i) {
        const int row = 64 * c + 8 * F.wave + i;
        if (row >= M) break;
        const float* hr = hres + (size_t)row * DM;
        float lg[8]; float ss = 0.f;
#pragma unroll
        for (int e = 0; e < 8; ++e) lg[e] = 0.f;
#pragma unroll
        for (int j = 0; j < 16; ++j) { const int k = F.lane + 64 * j; const float hv = hr[k]; ss += hv * hv;
            const LAS f32x4* rp = (const LAS f32x4*)(rw + k * 8); const f32x4 r0 = rp[0], r1 = rp[1];
            lg[0] += hv * r0[0]; lg[1] += hv * r0[1]; lg[2] += hv * r0[2]; lg[3] += hv * r0[3]; lg[4] += hv * r1[0]; lg[5] += hv * r1[1]; lg[6] += hv * r1[2]; lg[7] += hv * r1[3]; }
        ss = wave_sum(ss); const float rstd = 1.0f / sqrtf(ss * (1.0f / DM) + RMS_EPS);
#pragma unroll
        for (int e = 0; e < 8; ++e) lg[e] = wave_sum(lg[e]) * rstd;
        int e1 = 0; float v1 = lg[0];
#pragma unroll
        for (int e = 1; e < 8; ++e) if (lg[e] > v1) { v1 = lg[e]; e1 = e; }
        int e2 = -1; float v2 = -INFINITY;
#pragma unroll
        for (int e = 0; e < 8; ++e) if (e != e1 && (e2 < 0 || lg[e] > v2)) { v2 = lg[e]; e2 = e; }
        const float ex = __expf(v2 - v1); const float w1 = 1.0f / (1.0f + ex), w2 = ex / (1.0f + ex);
        if (F.lane == 0) { tok_e[2 * row] = e1; tok_e[2 * row + 1] = e2; tok_g[2 * row] = w1; tok_g[2 * row + 1] = w2; rstd_t[row] = rstd;
            __hip_atomic_fetch_add(&cnt[e1], 1, __ATOMIC_RELAXED, __HIP_MEMORY_SCOPE_WORKGROUP); __hip_atomic_fetch_add(&cnt[e2], 1, __ATOMIC_RELAXED, __HIP_MEMORY_SCOPE_WORKGROUP); }
    }
    __syncthreads();
    if (F.tid < NE && c < 256) ((int*)(ws + WS_HIST))[c * 8 + F.tid] = cnt[F.tid];
    __syncthreads();
}
__device__ __forceinline__ void assign_phase(const Frame& F, const Args& a) {
    unsigned char* ws = a.ws;
    LAS int* H = (LAS int*)(F.lds);
    LAS int* tot = H + 2048; LAS int* bef = tot + 8; LAS int* tst = bef + 8; LAS int* ntl = tst + 16;
    const int c = blockIdx.x;
    const int* hist = (const int*)(ws + WS_HIST);
    for (int i = F.tid; i < 2048; i += NWAVES * 64) H[i] = __hip_atomic_load(hist + i, __ATOMIC_RELAXED, __HIP_MEMORY_SCOPE_AGENT);
    __syncthreads();
    if (F.tid < NE) { int t = 0, bb = 0; for (int b2 = 0; b2 < 256; ++b2) { const int v = H[b2 * 8 + F.tid]; if (b2 < c) bb += v; t += v; } tot[F.tid] = t; bef[F.tid] = bb; }
    __syncthreads();
    if (F.tid == 0) { int s = 0; for (int e = 0; e < NE; ++e) { const int nt = (tot[e] + 255) >> 8; tst[e] = s; ntl[e] = nt; s += nt; } tst[8] = s; }
    __syncthreads();
    const int* tok_e = (const int*)(ws + WS_TOKE); int* tok_s = (int*)(ws + WS_TOKS); const float* rstd_t = (const float*)(ws + WS_RSTD);
    int* rowidx = (int*)(ws + WS_ROWIDX); float* rslot = (float*)(ws + WS_RSLOT);
    if (F.tid < NE && c < 256) { const int e = F.tid; int pos = 256 * tst[e] + bef[e];
        for (int i = 0; i < 64; ++i) { const int row = 64 * c + i;
            for (int k = 0; k < 2; ++k) if (tok_e[2 * row + k] == e) { rowidx[pos] = row; rslot[pos] = rstd_t[row]; tok_s[2 * row + k] = pos; ++pos; } } }
    if (c < NE) { const int e = c; const int lo = 256 * tst[e] + tot[e], hi2 = 256 * (tst[e] + ntl[e]);
        for (int s = lo + F.tid; s < hi2; s += NWAVES * 64) { rowidx[s] = 0; rslot[s] = 0.f; } }
    if (c == 0) { int* tile_e = (int*)(ws + WS_TILEE);
        if (F.tid < MAXT) { int e = 0; for (int q = 0; q < NE; ++q) if (F.tid >= tst[q] && F.tid < tst[q] + ntl[q]) e = q; tile_e[F.tid] = e; }
        if (F.tid == 0) *(int*)(ws + WS_NTIL) = tst[8]; }
    __syncthreads();
}
__device__ __forceinline__ void combine_phase(const Frame& F, const Args& a, bool poison) {
    unsigned char* ws = a.ws; float* out = a.out; const float* gfin = a.in[13];
    const int* tok_s = (const int*)(ws + WS_TOKS); const float* tok_g = (const float*)(ws + WS_TOKG); const bf16_t* Y = (const bf16_t*)(ws + WS_Y);
    const int gw = F.vcu * NWAVES + F.wave, NGW = F.G * NWAVES;
    f32x4 gf[4];
#pragma unroll
    for (int j = 0; j < 4; ++j) gf[j] = ((const f32x4*)gfin)[F.lane + 64 * j];
    for (int m = gw; m < M; m += NGW) {
        const int s1 = tok_s[2 * m], s2 = tok_s[2 * m + 1]; const float w1 = tok_g[2 * m], w2 = tok_g[2 * m + 1];
        f32x4* hr = (f32x4*)(out + (size_t)m * DM) + F.lane;
        const u32x2* y1 = (const u32x2*)(Y + (size_t)s1 * DM) + F.lane; const u32x2* y2 = (const u32x2*)(Y + (size_t)s2 * DM) + F.lane;
        f32x4 v[4]; float ss = 0.f;
#pragma unroll
        for (int j = 0; j < 4; ++j) { const f32x4 hv = hr[64 * j]; const u32x2 a1 = y1[64 * j], a2 = y2[64 * j];
            v[j][0] = hv[0] + w1 * __uint_as_float(a1.x << 16) + w2 * __uint_as_float(a2.x << 16);
            v[j][1] = hv[1] + w1 * __uint_as_float(a1.x & 0xffff0000u) + w2 * __uint_as_float(a2.x & 0xffff0000u);
            v[j][2] = hv[2] + w1 * __uint_as_float(a1.y << 16) + w2 * __uint_as_float(a2.y << 16);
            v[j][3] = hv[3] + w1 * __uint_as_float(a1.y & 0xffff0000u) + w2 * __uint_as_float(a2.y & 0xffff0000u);
            ss += (v[j][0] * v[j][0] + v[j][1] * v[j][1]) + (v[j][2] * v[j][2] + v[j][3] * v[j][3]); }
        ss = wave_sum(ss); float rstd = 1.0f / sqrtf(ss * (1.0f / DM) + RMS_EPS);
        if (poison) rstd = __builtin_nanf("");
#pragma unroll
        for (int j = 0; j < 4; ++j) hr[64 * j] = v[j] * rstd * gf[j];
    }
}

__global__ void __launch_bounds__(NWAVES * 64, 2) mega_fwd(Args args) {
    extern __shared__ __attribute__((aligned(16))) unsigned char lds[];
    Frame F;
    F.lds = (LAS unsigned char*)lds;
    F.tid = threadIdx.x; F.lane = F.tid & 63; F.wave = __builtin_amdgcn_readfirstlane(F.tid >> 6);
    F.G = gridDim.x; { const int bx = blockIdx.x; F.vcu = (F.G % 8 == 0) ? (bx % 8) * (F.G / 8) + bx / 8 : bx; }
    unsigned char* ws = args.ws;
    gu32* ctl = (gu32*)(ws + WS_CTL);
    for (int u = F.tid; u < (LDS_BYTES - LDSCTL_OFF) / 4; u += NWAVES * 64) ((LAS unsigned*)(F.lds + LDSCTL_OFF))[u] = 0u;
    __syncthreads();
    XcdBarrier bar = xcd_barrier_post((unsigned*)(ctl + CW_BAR), (volatile LAS unsigned*)(F.lds + MISC_OFF) + 8);
#define GRID_BAR() xcd_barrier(bar)
    bf16_t* HB = (bf16_t*)(ws + WS_HB); float* ssp = (float*)(ws + WS_SSP);
    bf16_t* QO = (bf16_t*)(ws + WS_QO); bf16_t* KB = (bf16_t*)(ws + WS_K); bf16_t* VB = (bf16_t*)(ws + WS_V);
    LAS unsigned char* ring = F.lds + RING_OFF;
    const int bx = (int)blockIdx.x;

    p0_prologue(F, args);
#if PROBE == 1
    GRID_BAR(); p0_prologue(F, args);
#endif
    GRID_BAR();
    {
        pg8::Gemm g{HB, (const bf16_t*)(ws + WS_WQKV0), M, NQKV, DM, nullptr, nullptr, 0}; pg8::StaticOrder S; S.init(M, NQKV, F.G, bx);
        pg8::EpiBf16<16> E{QO, DM, DM, (size_t)(WS_K - WS_QO) / 2, C2, ssp};
        pg8::gemm_phase<pg8::EpiBf16<16>, false, false>(ring, g, S, E);
    }
    GRID_BAR();
    {
#if PROBE == 4
        for (int i = 0; i < 4; ++i) { const int uid = F.vcu * 4 + i; if (uid >= NB * NH * 8) break; const int bh = uid >> 3, qb = uid & 7;
            att::sb_unit(bh >> 4, bh & 15, qb, QO, KB, VB, (bf16_t*)(ws + 340 * MiB), (LAS char*)ring); }
#endif
        for (int i = 0; i < 4; ++i) { const int uid = F.vcu * 4 + i; if (uid >= NB * NH * 8) break; const int bh = uid >> 3, qb = uid & 7;
            att::sb_unit(bh >> 4, bh & 15, qb, QO, KB, VB, QO, (LAS char*)ring); }
    }
    GRID_BAR();
    {
        pg8::Gemm g{QO, (const bf16_t*)(ws + WS_WO0), M, DM, DM, nullptr, nullptr, 0}; pg8::StaticOrder S; S.init(M, DM, F.G, bx);
        pg8::EpiRes E{args.in[0], args.out, HB, ssp};
        pg8::gemm_phase<pg8::EpiRes, false, false>(ring, g, S, E);
    }
    GRID_BAR();
    {
        pg8::Gemm g{HB, (const bf16_t*)(ws + WS_W13), M, 2 * FF, DM, nullptr, nullptr, 0}; pg8::StaticOrder S; S.init(M, 2 * FF, F.G, bx);
        pg8::EpiSwiglu<16> E{(bf16_t*)(ws + WS_HID0), FF, ssp};
        pg8::gemm_phase<pg8::EpiSwiglu<16>, false, false>(ring, g, S, E);
    }
    GRID_BAR();
    {
        pg8::Gemm g{(const bf16_t*)(ws + WS_HID0), (const bf16_t*)(ws + WS_W2), M, DM, FF, nullptr, nullptr, 0}; pg8::StaticOrder S; S.init(M, DM, F.G, bx);
        pg8::EpiRes E{args.out, args.out, HB, ssp};
        pg8::gemm_phase<pg8::EpiRes, false, false>(ring, g, S, E);
    }
    GRID_BAR();
    {
        pg8::Gemm g{HB, (const bf16_t*)(ws + WS_WQKV1), M, NQKV, DM, nullptr, nullptr, 0}; pg8::StaticOrder S; S.init(M, NQKV, F.G, bx);
        pg8::EpiBf16<16> E{QO, DM, DM, (size_t)(WS_K - WS_QO) / 2, C2, ssp};
        pg8::gemm_phase<pg8::EpiBf16<16>, false, false>(ring, g, S, E);
    }
    GRID_BAR();
    kmean_phase(F, KB, (float*)(ws + WS_KM));
    GRID_BAR();
    {
        if (F.G == 256) { const int bh = F.vcu >> 1, hf = F.vcu & 1;
#if PROBE == 5
            for (int i = 0; i < 4; ++i) { const int own = hf ? (i == 0 ? 1 : i == 1 ? 6 : i == 2 ? 2 : 5) : (i == 0 ? 0 : i == 1 ? 7 : i == 2 ? 3 : 4);
                att::moba_unit(bh >> 4, bh & 15, own, QO, KB, VB, (bf16_t*)(ws + 340 * MiB), (const float*)(ws + WS_KM), args.in[5], (LAS char*)ring); }
#endif
            for (int i = 0; i < 4; ++i) { const int own = hf ? (i == 0 ? 1 : i == 1 ? 6 : i == 2 ? 2 : 5) : (i == 0 ? 0 : i == 1 ? 7 : i == 2 ? 3 : 4);
                att::moba_fast<8>(bh >> 4, bh & 15, own, QO, KB, VB, QO, (const float*)(ws + WS_KM), args.in[5], (LAS char*)ring); } }
    }
    GRID_BAR();
    {
        pg8::Gemm g{QO, (const bf16_t*)(ws + WS_WO1), M, DM, DM, nullptr, nullptr, 0}; pg8::StaticOrder S; S.init(M, DM, F.G, bx);
        pg8::EpiRes E{args.out, args.out, HB, ssp};
        pg8::gemm_phase<pg8::EpiRes, false, false>(ring, g, S, E);
    }
    GRID_BAR();
    if (F.G == 256) router_phase(F, args);
    GRID_BAR();
    if (F.G == 256) assign_phase(F, args);
    GRID_BAR();
    const int ntiles = __builtin_amdgcn_readfirstlane(__hip_atomic_load((int*)(ws + WS_NTIL), __ATOMIC_RELAXED, __HIP_MEMORY_SCOPE_AGENT));
    {
        pg8::Gemm g{HB, (const bf16_t*)(ws + WS_E13), ntiles * 256, 2 * FE, DM, (const int*)(ws + WS_ROWIDX), (const int*)(ws + WS_TILEE), (size_t)2 * FE * DM}; pg8::StaticOrder S; S.init(ntiles * 256, 2 * FE, F.G, bx);
        pg8::EpiSwiglu<1> E{(bf16_t*)(ws + WS_H), FE, (const float*)(ws + WS_RSLOT)};
        pg8::gemm_phase<pg8::EpiSwiglu<1>, true, true>(ring, g, S, E);
#if PROBE == 2
        GRID_BAR(); pg8::gemm_phase<pg8::EpiSwiglu<1>, true, true>(ring, g, S, E);
#endif
    }
    GRID_BAR();
    {
        pg8::Gemm g{(const bf16_t*)(ws + WS_H), (const bf16_t*)(ws + WS_E2), ntiles * 256, DM, FE, nullptr, (const int*)(ws + WS_TILEE), (size_t)DM * FE}; pg8::StaticOrder S; S.init(ntiles * 256, DM, F.G, bx);
        pg8::EpiBf16<1> E{(bf16_t*)(ws + WS_Y), DM, 0, 0, 1.f, nullptr};
        pg8::gemm_phase<pg8::EpiBf16<1>, false, true>(ring, g, S, E);
#if PROBE == 3
        GRID_BAR(); pg8::gemm_phase<pg8::EpiBf16<1>, false, true>(ring, g, S, E);
#endif
    }
    GRID_BAR();
    {
        bool poison = (__hip_atomic_load(ctl + CW_BAR + XB_TMO, __ATOMIC_RELAXED, __HIP_MEMORY_SCOPE_AGENT) != 0u) || (F.G != 256);
        combine_phase(F, args, poison);
    }
}

extern "C" void kernel_launch(void* const* d_in, const int* in_sizes, int n_in, void* d_out, int out_size, void* d_ws, size_t ws_size, hipStream_t stream) {
    static int grid = 0;
    if (grid == 0) {
        if (n_in != 14 || in_sizes[0] != M * DM || out_size != M * DM || ws_size < WS_END) { fprintf(stderr, "kernel_launch: unexpected shapes or workspace (%zu < %zu); nothing launched\n", ws_size, (size_t)WS_END); grid = -1; return; }
        int dev = 0, cus = 0, per_cu = 0;
        if (hipGetDevice(&dev) != hipSuccess || hipDeviceGetAttribute(&cus, hipDeviceAttributeMultiprocessorCount, dev) != hipSuccess) { grid = -1; return; }
        if (hipFuncSetAttribute((const void*)mega_fwd, hipFuncAttributeMaxDynamicSharedMemorySize, LDS_BYTES) != hipSuccess) { fprintf(stderr, "kernel_launch: hipFuncSetAttribute failed\n"); grid = -1; return; }
        if (hipOccupancyMaxActiveBlocksPerMultiprocessor(&per_cu, (const void*)mega_fwd, NWAVES * 64, LDS_BYTES) != hipSuccess || per_cu < 1) { fprintf(stderr, "kernel_launch: occupancy query reports %d\n", per_cu); }
        (void)hipGetLastError();
        grid = cus;
    }
    if (grid < 0) return;
    if (hipMemsetAsync((char*)d_ws + WS_CTL, 0, CTL_ZERO_BYTES, stream) != hipSuccess) return;
    Args a{};
    for (int i = 0; i < 14; ++i) a.in[i] = (const float*)d_in[i];
    a.out = (float*)d_out; a.ws = (unsigned char*)d_ws;
    hipLaunchKernelGGL(mega_fwd, dim3(grid), dim3(NWAVES * 64), LDS_BYTES, stream, a);
}
```

```cpp
#include <hip/hip_runtime.h>
#include <cstdio>
#include <cstdint>

#define GAS __attribute__((address_space(1)))
#define LAS __attribute__((address_space(3)))
typedef unsigned short bf16_t;
typedef short bf16x8 __attribute__((ext_vector_type(8)));
typedef short s16x4 __attribute__((ext_vector_type(4)));
typedef short v4i16_t __attribute__((ext_vector_type(4)));
typedef float f32x4 __attribute__((ext_vector_type(4)));
typedef float f32x16 __attribute__((ext_vector_type(16)));
typedef unsigned u32x4 __attribute__((ext_vector_type(4)));
typedef unsigned u32x2 __attribute__((ext_vector_type(2)));
typedef float f32x2_t __attribute__((ext_vector_type(2)));
typedef __bf16 bf16x2_t __attribute__((ext_vector_type(2)));
typedef GAS unsigned gu32;

constexpr int NB = 8, SEQ = 2048, DM = 1024, NH = 16, HD = 64, M = NB * SEQ;
constexpr int FF = 2816, NE = 8, FE = 3584, NQKV = 3 * DM;
constexpr int MAXT = 135, MAXSLOT = MAXT * 256;
constexpr float RMS_EPS = 1e-6f;
constexpr float LOG2E = 1.4426950408889634f;
constexpr float C2 = 0.125f * LOG2E;
constexpr int NWAVES = 8;
#define PROBE 0

__device__ __forceinline__ unsigned cvtpk(float lo, float hi) { f32x2_t v = {lo, hi}; bf16x2_t b = __builtin_convertvector(v, bf16x2_t); return __builtin_bit_cast(unsigned, b); }
__device__ __forceinline__ float bf2f(unsigned short x) { return __uint_as_float((unsigned)x << 16); }
__device__ __forceinline__ float wave_sum(float v) {
#pragma unroll
    for (int o = 1; o < 64; o <<= 1) v += __shfl_xor(v, o);
    return v;
}

namespace pg8 {
constexpr int BM = 256, BK = 64, HALF = 128, HTB = HALF * BK * 2, STAGE_BYTES = 8 * HTB, NXCD = 8, WGM = 8;
__host__ __device__ __forceinline__ int lds_byte(int r, int c) { const int st = (r >> 4) * 2 + (c >> 5), rr = r & 15, cc = c & 31, ob = rr * 64 + cc * 2; return st * 1024 + (ob ^ (((ob >> 9) & 1) << 5)); }
__host__ __device__ __forceinline__ void stage_rc(int b, int& R, int& C) { const int st = b / 1024, sb = b % 1024, swz = sb ^ (((sb >> 9) & 1) << 5); R = (st >> 1) * 16 + swz / 64; C = (st & 1) * 32 + (swz % 64) / 2; }
__host__ __device__ __forceinline__ int perm32(int rho) { const int n = rho >> 4, i = rho & 15; return 8 * (i >> 2) + 4 * n + (i & 3); }

struct Unit { int pm, pn; };
struct Gemm { const bf16_t* A; const bf16_t* Bt; int M, N, K; const int* rowidx; const int* tile_e; size_t estride; };

struct StaticOrder {
    int nM, nN, nwg, G, c;
    __host__ __device__ void init(int M_, int N_, int G_, int c_) { nM = M_ / BM; nN = N_ / BM; nwg = nM * nN; G = G_; c = c_; }
    __host__ __device__ bool next(int i, Unit& u) const {
        const long L = (long)i * G + c; if (L >= nwg) return false;
        int wgid = (int)L; { const int q = nwg / NXCD, r = nwg % NXCD, xcd = wgid % NXCD, off = wgid / NXCD; wgid = (xcd < r ? xcd * (q + 1) : r * (q + 1) + (xcd - r) * q) + off; }
        const int nig = WGM * nN, gid = wgid / nig, fm = gid * WGM, gsz = (nM - fm) < WGM ? (nM - fm) : WGM;
        u.pm = fm + ((wgid % nig) % gsz); u.pn = (wgid % nig) / gsz; return true;
    }
};

template <int NP> struct RowScale {
    const float* p;
    __device__ __forceinline__ float get(int row) const {
        if constexpr (NP == 16) { const f32x4* q = (const f32x4*)(p + (size_t)row * 16); const f32x4 a = q[0], b = q[1], c = q[2], d = q[3];
            const float s = ((a[0] + a[1]) + (a[2] + a[3])) + ((b[0] + b[1]) + (b[2] + b[3])) + ((c[0] + c[1]) + (c[2] + c[3])) + ((d[0] + d[1]) + (d[2] + d[3]));
            return __builtin_amdgcn_rsqf(s * (1.0f / DM) + RMS_EPS); }
        else return p[row];
    }
};

template <int NP> struct EpiBf16 {
    static constexpr bool PERM = true;
    bf16_t* O; int ldc; int split_cols; size_t split_stride; float scale0; const float* rs;
    __device__ __forceinline__ void operator()(const f32x4 (&acc)[2][2][4][2], const Unit& u, int wr, int wc, int fr, int fq) const {
        const int row0 = u.pm * BM + wr * 64 + fr; int colt = u.pn * BM; bf16_t* base = O;
        float sc = 1.f; if (split_cols) { const int t = colt / split_cols; base += (size_t)t * split_stride; colt -= t * split_cols; if (t == 0) sc = scale0; }
        const int col0 = colt + wc * 32 + 8 * fq;
        const RowScale<NP> R{rs};
#pragma unroll
        for (int ai = 0; ai < 2; ++ai)
#pragma unroll
            for (int m = 0; m < 4; ++m) { const int row = row0 + ai * HALF + m * 16; bf16_t* rowp = base + (size_t)row * ldc + col0;
                const float s = rs ? R.get(row) * sc : sc;
#pragma unroll
                for (int bj = 0; bj < 2; ++bj) { const f32x4 v0 = acc[ai][bj][m][0] * s, v1 = acc[ai][bj][m][1] * s;
                    u32x4 w; w.x = cvtpk(v0[0], v0[1]); w.y = cvtpk(v0[2], v0[3]); w.z = cvtpk(v1[0], v1[1]); w.w = cvtpk(v1[2], v1[3]);
                    *(u32x4*)(rowp + bj * HALF) = w; } }
    }
};
template <int NP> struct EpiSwiglu {
    static constexpr bool PERM = true;
    bf16_t* O; int ldc; const float* rs;
    __device__ __forceinline__ void operator()(const f32x4 (&acc)[2][2][4][2], const Unit& u, int wr, int wc, int fr, int fq) const {
        const int row0 = u.pm * BM + wr * 64 + fr; const int col0 = u.pn * HALF + wc * 32 + 8 * fq;
        const RowScale<NP> R{rs};
#pragma unroll
        for (int ai = 0; ai < 2; ++ai)
#pragma unroll
            for (int m = 0; m < 4; ++m) { const int row = row0 + ai * HALF + m * 16; const float r = R.get(row);
                float hv[8];
#pragma unroll
                for (int n = 0; n < 2; ++n)
#pragma unroll
                    for (int e = 0; e < 4; ++e) { const float g = acc[ai][0][m][n][e] * r, uu = acc[ai][1][m][n][e] * r;
                        const float sg = __builtin_amdgcn_rcpf(1.0f + __builtin_amdgcn_exp2f(-g * LOG2E));
                        hv[n * 4 + e] = g * sg * uu; }
                u32x4 w; w.x = cvtpk(hv[0], hv[1]); w.y = cvtpk(hv[2], hv[3]); w.z = cvtpk(hv[4], hv[5]); w.w = cvtpk(hv[6], hv[7]);
                *(u32x4*)(O + (size_t)row * ldc + col0) = w; }
    }
};
struct EpiRes {
    static constexpr bool PERM = true;
    const float* base; float* out; bf16_t* hb; float* ssp;
    __device__ __forceinline__ void operator()(const f32x4 (&acc)[2][2][4][2], const Unit& u, int wr, int wc, int fr, int fq) const {
        const int row0 = u.pm * BM + wr * 64 + fr; const int col0 = u.pn * BM + wc * 32 + 8 * fq;
#pragma unroll
        for (int ai = 0; ai < 2; ++ai)
#pragma unroll
            for (int m = 0; m < 4; ++m) { const int row = row0 + ai * HALF + m * 16; const size_t off = (size_t)row * DM + col0; float ss = 0.f;
#pragma unroll
                for (int bj = 0; bj < 2; ++bj) { const f32x4 b0 = *(const f32x4*)(base + off + bj * HALF), b1 = *(const f32x4*)(base + off + bj * HALF + 4);
                    const f32x4 v0 = acc[ai][bj][m][0] + b0, v1 = acc[ai][bj][m][1] + b1;
                    *(f32x4*)(out + off + bj * HALF) = v0; *(f32x4*)(out + off + bj * HALF + 4) = v1;
                    u32x4 w; w.x = cvtpk(v0[0], v0[1]); w.y = cvtpk(v0[2], v0[3]); w.z = cvtpk(v1[0], v1[1]); w.w = cvtpk(v1[2], v1[3]);
                    *(u32x4*)(hb + off + bj * HALF) = w;
                    ss += ((v0[0] * v0[0] + v0[1] * v0[1]) + (v0[2] * v0[2] + v0[3] * v0[3])) + ((v1[0] * v1[0] + v1[1] * v1[1]) + (v1[2] * v1[2] + v1[3] * v1[3])); }
                ss += __shfl_xor(ss, 16); ss += __shfl_xor(ss, 32);
                if (fq == 0) ssp[(size_t)row * 16 + u.pn * 4 + wc] = ss; }
    }
};

template <class Epi, bool GATHER, bool EXPB>
__device__ __forceinline__ void gemm_phase(LAS unsigned char* lds, const Gemm g, const StaticOrder& S, const Epi& E) {
    int tid = threadIdx.x; asm volatile("" : "+v"(tid));
    const int wid = __builtin_amdgcn_readfirstlane(tid >> 6), lane = tid & 63, wr = wid >> 2, wc = wid & 3, fr = lane & 15, fq = lane >> 4;
    const int K = g.K, nt = K / BK;
    const size_t kstep = (size_t)(BK * 2);
    const size_t hstep = (size_t)HALF * K * 2;
    const size_t tstep = 2 * hstep;
    int Rr[2], Cc[2]; unsigned voffB[2];
    unsigned vA[2][2], vN[2][2];
#pragma unroll
    for (int i = 0; i < 2; ++i) { int R, C; stage_rc(tid * 16 + i * 8192, R, C); Rr[i] = R; Cc[i] = C; const int Rb = Epi::PERM ? ((R & ~31) + perm32(R & 31)) : R;
        voffB[i] = (unsigned)(Rb * K + C) * 2u;
        vA[0][i] = (unsigned)(R * K + C) * 2u; vA[1][i] = vA[0][i] + (unsigned)hstep; vN[0][i] = vA[0][i]; vN[1][i] = vA[1][i]; }
    const unsigned ldsw = (unsigned)wid * 1024u;
    const int aoff = lds_byte(wr * 64 + fr, fq * 8), boff = lds_byte(wc * 32 + fr, fq * 8);
#define PG8_SA(b, h) (((b) * 2 + (h)) * HTB)
#define PG8_SB(b, h) ((4 + (b) * 2 + (h)) * HTB)
#define PG8_STAGE(bufoff, gbase, voff) do { _Pragma("unroll") for (int _i = 0; _i < 2; ++_i) \
        __builtin_amdgcn_global_load_lds((const unsigned*)((const char*)(gbase) + (voff)[_i]), (LAS unsigned*)(lds + (bufoff) + ldsw + _i * 8192), 16, 0, 0); } while (0)
#define PG8_LDA(dst, b, h) do { _Pragma("unroll") for (int m = 0; m < 4; ++m) _Pragma("unroll") for (int k = 0; k < 2; ++k) dst[m][k] = *(const LAS bf16x8*)(lds + PG8_SA(b, h) + aoff + m * 2048 + k * 1024); } while (0)
#define PG8_LDB(dst, b, h) do { _Pragma("unroll") for (int n = 0; n < 2; ++n) _Pragma("unroll") for (int k = 0; k < 2; ++k) dst[n][k] = *(const LAS bf16x8*)(lds + PG8_SB(b, h) + boff + n * 2048 + k * 1024); } while (0)
#define PG8_MMA(ai, bj, At, Bt) do { __builtin_amdgcn_s_setprio(1); _Pragma("unroll") for (int m = 0; m < 4; ++m) _Pragma("unroll") for (int n = 0; n < 2; ++n) _Pragma("unroll") for (int k = 0; k < 2; ++k) \
        acc[ai][bj][m][n] = __builtin_amdgcn_mfma_f32_16x16x32_bf16(Bt[n][k], At[m][k], acc[ai][bj][m][n], 0, 0, 0); __builtin_amdgcn_s_setprio(0); } while (0)
#define PG8_WAIT_V(n) asm volatile("s_waitcnt vmcnt(" #n ")" ::: "memory")
#define PG8_WAIT_L(n) asm volatile("s_waitcnt lgkmcnt(" #n ")" ::: "memory")
#define PG8_BAR __builtin_amdgcn_s_barrier()
#define PG8_SCHED __builtin_amdgcn_sched_barrier(0)
#define PG8_APTR(u) (GATHER ? (const char*)g.A : (const char*)g.A + (size_t)(u).pm * tstep)
#define PG8_BPTR(u) ((const char*)g.Bt + (EXPB ? (size_t)__builtin_amdgcn_readfirstlane(__hip_atomic_load(g.tile_e + (u).pm, __ATOMIC_RELAXED, __HIP_MEMORY_SCOPE_AGENT)) * g.estride * 2 : (size_t)0) + (size_t)(u).pn * tstep)
#define PG8_GOFF(dst, u) do { _Pragma("unroll") for (int _h = 0; _h < 2; ++_h) _Pragma("unroll") for (int _i = 0; _i < 2; ++_i) \
        dst[_h][_i] = (unsigned)g.rowidx[(u).pm * BM + _h * HALF + Rr[_i]] * (unsigned)(K * 2) + (unsigned)(Cc[_i] * 2); } while (0)
    Unit cur, nxt; int ui = 0;
    if (!S.next(0, cur)) return;
    f32x4 acc[2][2][4][2];
#pragma unroll
    for (int a = 0; a < 2; ++a)
#pragma unroll
        for (int b = 0; b < 2; ++b)
#pragma unroll
            for (int m = 0; m < 4; ++m)
#pragma unroll
                for (int n = 0; n < 2; ++n) acc[a][b][m][n] = (f32x4){0.f, 0.f, 0.f, 0.f};
    bf16x8 At[4][2], B0[2][2], B1[2][2];
    const char* cA = PG8_APTR(cur); const char* cB = PG8_BPTR(cur);
    if constexpr (GATHER) { PG8_GOFF(vA, cur); }
    PG8_STAGE(PG8_SB(0, 0), cB, voffB); PG8_STAGE(PG8_SB(0, 1), cB + hstep, voffB); PG8_STAGE(PG8_SA(0, 0), cA, vA[0]); PG8_STAGE(PG8_SA(0, 1), cA, vA[1]);
    if (wr == 1) PG8_BAR;
    PG8_WAIT_V(2); PG8_BAR;
    PG8_STAGE(PG8_SB(1, 0), cB + kstep, voffB); PG8_STAGE(PG8_SA(1, 0), cA + kstep, vA[0]); PG8_STAGE(PG8_SB(1, 1), cB + hstep + kstep, voffB);
    PG8_WAIT_V(6); PG8_BAR;
    for (;;) {
        const bool has_next = S.next(ui + 1, nxt);
        const char* nA = has_next ? PG8_APTR(nxt) : cA; const char* nB = has_next ? PG8_BPTR(nxt) : cB;
        if constexpr (GATHER) { if (has_next) { PG8_GOFF(vN, nxt); } else {
#pragma unroll
            for (int h = 0; h < 2; ++h)
#pragma unroll
                for (int i = 0; i < 2; ++i) vN[h][i] = vA[h][i]; } }
        for (int t = 0; t < nt; t += 2) {
            const bool last = (t == nt - 2);
            const char* a1 = cA + (size_t)(t + 1) * kstep;
            const char* a2 = last ? nA : cA + (size_t)(t + 2) * kstep; const char* b2 = last ? nB : cB + (size_t)(t + 2) * kstep;
            const char* a3 = a2 + kstep; const char* b3 = b2 + kstep;
            unsigned v2[2][2];
#pragma unroll
            for (int h = 0; h < 2; ++h)
#pragma unroll
                for (int i = 0; i < 2; ++i) v2[h][i] = (GATHER && last) ? vN[h][i] : vA[h][i];
            PG8_LDB(B0, 0, 0); PG8_LDB(B1, 0, 1); PG8_SCHED; PG8_LDA(At, 0, 0); PG8_STAGE(PG8_SA(1, 1), a1, vA[1]);
            PG8_WAIT_V(8); PG8_WAIT_L(0); PG8_BAR; PG8_MMA(0, 0, At, B0); PG8_MMA(0, 1, At, B1); PG8_BAR; PG8_SCHED;
            PG8_LDA(At, 0, 1); PG8_STAGE(PG8_SB(0, 0), b2, voffB); PG8_STAGE(PG8_SB(0, 1), b2 + hstep, voffB); PG8_STAGE(PG8_SA(0, 0), a2, v2[0]);
            PG8_WAIT_V(8); PG8_WAIT_L(0); PG8_BAR; PG8_MMA(1, 0, At, B0); PG8_MMA(1, 1, At, B1); PG8_BAR; PG8_SCHED;
            PG8_LDB(B0, 1, 0); PG8_LDB(B1, 1, 1); PG8_SCHED; PG8_LDA(At, 1, 0); PG8_STAGE(PG8_SA(0, 1), a2, v2[1]);
            PG8_WAIT_V(8); PG8_WAIT_L(0); PG8_BAR; PG8_MMA(0, 0, At, B0); PG8_MMA(0, 1, At, B1); PG8_BAR; PG8_SCHED;
            PG8_LDA(At, 1, 1); PG8_STAGE(PG8_SB(1, 0), b3, voffB); PG8_STAGE(PG8_SB(1, 1), b3 + hstep, voffB); PG8_STAGE(PG8_SA(1, 0), a3, v2[0]);
            PG8_WAIT_V(8); PG8_WAIT_L(0); PG8_BAR; PG8_MMA(1, 0, At, B0); PG8_MMA(1, 1, At, B1); PG8_BAR; PG8_SCHED;
        }
        if (wr == 0) PG8_BAR;
        E(acc, cur, wr, wc, fr, fq);
        if (!has_next) break;
#pragma unroll
        for (int a = 0; a < 2; ++a)
#pragma unroll
            for (int b = 0; b < 2; ++b)
#pragma unroll
                for (int m = 0; m < 4; ++m)
#pragma unroll
                    for (int n = 0; n < 2; ++n) acc[a][b][m][n] = (f32x4){0.f, 0.f, 0.f, 0.f};
        cur = nxt; cA = nA; cB = nB; ++ui;
#pragma unroll
        for (int h = 0; h < 2; ++h)
#pragma unroll
            for (int i = 0; i < 2; ++i) vA[h][i] = vN[h][i];
        if (wr == 1) PG8_BAR;
    }
    PG8_WAIT_V(0);
    PG8_BAR;
#undef PG8_SA
#undef PG8_SB
#undef PG8_STAGE
#undef PG8_LDA
#undef PG8_LDB
#undef PG8_MMA
#undef PG8_WAIT_V
#undef PG8_WAIT_L
#undef PG8_BAR
#undef PG8_SCHED
#undef PG8_APTR
#undef PG8_BPTR
#undef PG8_GOFF
}
}

__device__ __forceinline__ void cvt_load(const float* W, int N, int item, int lane, f32x4 (&v)[8]) {
    const int nblk = N / 32, kb = item / nblk, nb = item - kb * nblk, k0 = 64 * kb, n0 = 32 * nb;
    const int nq = lane & 7, ko = lane >> 3;
    const float* src = W + (size_t)(k0 + 8 * ko) * N + n0 + 4 * nq;
#pragma unroll
    for (int jj = 0; jj < 8; ++jj) v[jj] = __builtin_nontemporal_load((const f32x4*)(src + (size_t)jj * N));
}
__device__ __forceinline__ void cvt_store(int K, int N, const float* g, bf16_t* WT, int mode, int item, int lane, f32x4 (&v)[8]) {
    const int nblk = N / 32, kb = item / nblk, nb = item - kb * nblk, k0 = 64 * kb, n0 = 32 * nb;
    const int nq = lane & 7, ko = lane >> 3;
    if (g) { const f32x4 g0 = *(const f32x4*)(g + k0 + 8 * ko), g1 = *(const f32x4*)(g + k0 + 8 * ko + 4);
#pragma unroll
        for (int jj = 0; jj < 4; ++jj) { v[jj] = v[jj] * g0[jj]; v[4 + jj] = v[4 + jj] * g1[jj]; } }
#pragma unroll
    for (int i = 0; i < 4; ++i) { const int n = n0 + 4 * nq + i; const int row = mode == 0 ? n : (256 * (n >> 7) + (n & 127) + (mode == 2 ? 128 : 0));
        u32x4 o; o.x = cvtpk(v[0][i], v[1][i]); o.y = cvtpk(v[2][i], v[3][i]); o.z = cvtpk(v[4][i], v[5][i]); o.w = cvtpk(v[6][i], v[7][i]);
        *(u32x4*)(WT + (size_t)row * K + k0 + 8 * ko) = o; }
}
__device__ __forceinline__ void cvt_item(const float* W, int K, int N, const float* g, bf16_t* WT, int mode, int item, int lane) {
    f32x4 v[8]; cvt_load(W, N, item, lane, v); cvt_store(K, N, g, WT, mode, item, lane, v);
}
constexpr int I_E13 = 16 * 112, I_E2 = 56 * 32, N_EXP_ITEMS = 16 * I_E13 + 8 * I_E2;
struct ExpCvt { const float* e_w1; const float* e_w3; const float* e_w2; const float* g; bf16_t* E13; bf16_t* E2; int next, stride; };
struct ExpJob { const float* W; const float* g; bf16_t* WT; int K, N, mode, item; };
__device__ __forceinline__ ExpJob exp_decode(const ExpCvt& C, int it) {
    ExpJob j; int r = it;
    if (r < 8 * I_E13) { const int e = r / I_E13; r -= e * I_E13; j.W = C.e_w1 + (size_t)e * DM * FE; j.g = C.g; j.WT = C.E13 + (size_t)e * 2 * FE * DM; j.K = DM; j.N = FE; j.mode = 1; j.item = r; return j; } r -= 8 * I_E13;
    if (r < 8 * I_E13) { const int e = r / I_E13; r -= e * I_E13; j.W = C.e_w3 + (size_t)e * DM * FE; j.g = C.g; j.WT = C.E13 + (size_t)e * 2 * FE * DM; j.K = DM; j.N = FE; j.mode = 2; j.item = r; return j; } r -= 8 * I_E13;
    { const int e = r / I_E2; r -= e * I_E2; j.W = C.e_w2 + (size_t)e * FE * DM; j.g = nullptr; j.WT = C.E2 + (size_t)e * DM * FE; j.K = FE; j.N = DM; j.mode = 0; j.item = r; return j; }
}

namespace att {
constexpr int SLOTB = 8192;
constexpr int NSLOT = 3;
constexpr int L_K = 0, L_V = NSLOT * SLOTB, L_WS = 2 * NSLOT * SLOTB, L_OST = L_WS + NWAVES * 256, L_TAB = L_OST + NWAVES * 4096, L_FLAG = L_TAB + 4096, L_BYTES = L_FLAG + 256;
#define SBAR() __builtin_amdgcn_sched_barrier(0)
#define WAIT_BAR0() asm volatile("s_waitcnt vmcnt(0) lgkmcnt(0)\n\ts_barrier" ::: "memory")
__device__ __forceinline__ int crow(int r, int hi) { return (r & 3) + 8 * (r >> 2) + 4 * hi; }
__device__ __forceinline__ void glds16(const void* gsrc, unsigned lds_dst) { unsigned keep;
    asm volatile("s_mov_b32 %0, m0\n\ts_mov_b32 m0, %2\n\ts_nop 0\n\tglobal_load_lds_dwordx4 %1, off\n\ts_mov_b32 m0, %0" : "=&s"(keep) : "v"(gsrc), "s"(lds_dst) : "memory"); }
__device__ __forceinline__ void qkt(f32x16& p0, f32x16& p1, const LAS char* Kslot, const bf16x8* qr, const f32x16& c0, int r32, int hi) {
    const LAS char* kb = Kslot + hi * 1024 + r32 * 16;
#pragma unroll
    for (int d0 = 0; d0 < 4; ++d0) {
        const bf16x8 b0 = *(const LAS bf16x8*)(kb + d0 * 2048);
        const bf16x8 b1 = *(const LAS bf16x8*)(kb + d0 * 2048 + 512);
        if (d0 == 0) { p0 = __builtin_amdgcn_mfma_f32_32x32x16_bf16(b0, qr[0], c0, 0, 0, 0); p1 = __builtin_amdgcn_mfma_f32_32x32x16_bf16(b1, qr[0], c0, 0, 0, 0); }
        else { p0 = __builtin_amdgcn_mfma_f32_32x32x16_bf16(b0, qr[d0], p0, 0, 0, 0); p1 = __builtin_amdgcn_mfma_f32_32x32x16_bf16(b1, qr[d0], p1, 0, 0, 0); } }
}
__device__ __forceinline__ void pv(f32x16* o, int vb, bf16x8 pa0, bf16x8 pa1, bf16x8 pa2, bf16x8 pa3) {
#pragma unroll
    for (int d0 = 0; d0 < 2; ++d0) { s16x4 lo[4], hi[4];
#pragma unroll
        for (int ks = 0; ks < 4; ++ks) {
            asm volatile("ds_read_b64_tr_b16 %0,%1 offset:%c2" : "=&v"(lo[ks]) : "v"(vb), "i"(d0 * 4096 + ks * 1024) : "memory");
            asm volatile("ds_read_b64_tr_b16 %0,%1 offset:%c2" : "=&v"(hi[ks]) : "v"(vb), "i"(d0 * 4096 + ks * 1024 + 512) : "memory"); }
        asm volatile("s_waitcnt lgkmcnt(0)" ::: "memory"); SBAR();
#define PK(k) (bf16x8){lo[k][0], lo[k][1], lo[k][2], lo[k][3], hi[k][0], hi[k][1], hi[k][2], hi[k][3]}
        o[d0] = __builtin_amdgcn_mfma_f32_32x32x16_bf16(pa0, PK(0), o[d0], 0, 0, 0);
        o[d0] = __builtin_amdgcn_mfma_f32_32x32x16_bf16(pa1, PK(1), o[d0], 0, 0, 0);
        o[d0] = __builtin_amdgcn_mfma_f32_32x32x16_bf16(pa2, PK(2), o[d0], 0, 0, 0);
        o[d0] = __builtin_amdgcn_mfma_f32_32x32x16_bf16(pa3, PK(3), o[d0], 0, 0, 0);
#undef PK
    }
}
__device__ __forceinline__ float swap_sum(float v) { auto rr = __builtin_amdgcn_permlane32_swap(__float_as_uint(v), __float_as_uint(v), false, false); return __uint_as_float(rr[0]) + __uint_as_float(rr[1]); }
__device__ __forceinline__ float swap_max(float v) { auto rr = __builtin_amdgcn_permlane32_swap(__float_as_uint(v), __float_as_uint(v), false, false); return __builtin_fmaxf(__uint_as_float(rr[0]), __uint_as_float(rr[1])); }
__device__ __forceinline__ float swap_other(float v, int hi) { auto rr = __builtin_amdgcn_permlane32_swap(__float_as_uint(v), __float_as_uint(v), false, false); return __uint_as_float(hi ? rr[0] : rr[1]); }

#define PKW(P, B) cvtpk(P[B], P[B + 1])
__device__ __forceinline__ void store_o(const f32x16* o, const float* rli, bf16_t* Ow, LAS char* shm, int wid, int lane, int r32, int hi) {
    LAS bf16_t* stg = (LAS bf16_t*)(shm + L_OST) + wid * 2048;
#pragma unroll
    for (int r = 0; r < 16; ++r) { const int orow = crow(r, hi);
#pragma unroll
        for (int d0 = 0; d0 < 2; ++d0) stg[orow * 64 + d0 * 32 + r32] = (bf16_t)(cvtpk(o[d0][r] * rli[r], 0.f) & 0xffffu); }
    asm volatile("s_waitcnt lgkmcnt(0)" ::: "memory");
#pragma unroll
    for (int i = 0; i < 4; ++i) { const int row = i * 8 + (lane >> 3), ch = lane & 7; const u32x4 v = *(const LAS u32x4*)(stg + row * 64 + ch * 8); *(u32x4*)(Ow + (size_t)row * DM + ch * 8) = v; }
}

__device__ __forceinline__ void sb_half(f32x16& P, float carry_in, float& total, int hi, int t, int s_base) {
    float L[16], lw[16];
#pragma unroll
    for (int r = 0; r < 16; ++r) { const float z = P[r]; const float az = __builtin_fabsf(z);
        const float sp = __builtin_fmaxf(z, 0.f) + __builtin_amdgcn_logf(1.0f + __builtin_amdgcn_exp2f(-az));
        const bool valid = (s_base + crow(r, hi)) < t;
        L[r] = valid ? -sp : 0.f; lw[r] = valid ? (z - sp) : -INFINITY; }
    float G[4], T[4], Gp[4];
#pragma unroll
    for (int g = 0; g < 4; ++g) { G[g] = (L[4 * g] + L[4 * g + 1]) + (L[4 * g + 2] + L[4 * g + 3]);
        auto rr = __builtin_amdgcn_permlane32_swap(__float_as_uint(G[g]), __float_as_uint(G[g]), false, false);
        T[g] = __uint_as_float(rr[0]) + __uint_as_float(rr[1]); Gp[g] = __uint_as_float(hi ? rr[0] : rr[1]); }
    float st = carry_in;
#pragma unroll
    for (int g = 3; g >= 0; --g) {
        float a = st + (hi ? 0.f : Gp[g]);
        P[4 * g + 3] = __builtin_amdgcn_exp2f(lw[4 * g + 3] + a); a += L[4 * g + 3];
        P[4 * g + 2] = __builtin_amdgcn_exp2f(lw[4 * g + 2] + a); a += L[4 * g + 2];
        P[4 * g + 1] = __builtin_amdgcn_exp2f(lw[4 * g + 1] + a); a += L[4 * g + 1];
        P[4 * g + 0] = __builtin_amdgcn_exp2f(lw[4 * g + 0] + a);
        st += T[g]; }
    total = (T[0] + T[1]) + (T[2] + T[3]);
}
__device__ __forceinline__ void sb_unit(int b, int h, int qb, const bf16_t* Q, const bf16_t* K, const bf16_t* V, bf16_t* O, LAS char* shm, ExpCvt& C) {
    int tid = threadIdx.x; asm volatile("" : "+v"(tid));
    const int lane = tid & 63, r32 = lane & 31, hi = lane >> 5; const int wid = __builtin_amdgcn_readfirstlane(tid >> 6);
    const size_t rowbase = (size_t)b * SEQ; const int q0 = qb * 256;
    const bf16_t* Qw = Q + (rowbase + q0 + wid * 32) * DM + h * HD;
    const bf16_t* Kh = K + rowbase * DM + h * HD; const bf16_t* Vh = V + rowbase * DM + h * HD;
    const unsigned lds0 = (unsigned)(uintptr_t)shm;
    const bf16_t* ksrc = Kh + (size_t)lane * DM + wid * 8;
    const bf16_t* vsrc = Vh + (size_t)(16 * (wid & 3) + (lane >> 2)) * DM + (wid >> 2) * 32 + (lane & 3) * 8;
    const unsigned kdst = lds0 + L_K + wid * 1024, vdst = lds0 + L_V + wid * 1024;
    const int vb0 = (int)(lds0 + L_V) + ((lane >> 4) & 1) * 32 + (lane & 3) * 8 + (4 * hi + ((lane & 15) >> 2)) * 64;
    LAS int* flags = (LAS int*)(shm + L_FLAG);
    bf16x8 qr[4];
#pragma unroll
    for (int d0 = 0; d0 < 4; ++d0) qr[d0] = *(const bf16x8*)(Qw + (size_t)r32 * DM + d0 * 16 + hi * 8);
    const int t = q0 + wid * 32 + r32;
    const int jtw = (q0 + wid * 32) >> 6;
    f32x16 o[2]; o[0] = f32x16{}; o[1] = f32x16{};
    float carry = 0.f; bool mydone = false;
    int cur = 4 * qb + 3, slot = 0, it = 0;
    f32x4 cv[8]; int cpend = -1;
    glds16(ksrc + (size_t)cur * 64 * DM, (unsigned)__builtin_amdgcn_readfirstlane(kdst));
    glds16(vsrc + (size_t)cur * 64 * DM, (unsigned)__builtin_amdgcn_readfirstlane(vdst));
    for (;;) {
        WAIT_BAR0();
        if (it > 0) {
            int all = 1;
#pragma unroll
            for (int w = 0; w < NWAVES; ++w) all &= flags[((it - 1) & 1) * NWAVES + w];
            if (__builtin_amdgcn_readfirstlane(all)) break;
        }
        if (cur > 0) { glds16(ksrc + (size_t)(cur - 1) * 64 * DM, (unsigned)__builtin_amdgcn_readfirstlane(kdst + (slot ^ 1) * SLOTB));
                       glds16(vsrc + (size_t)(cur - 1) * 64 * DM, (unsigned)__builtin_amdgcn_readfirstlane(vdst + (slot ^ 1) * SLOTB)); }
        if (cpend >= 0) { const ExpJob j = exp_decode(C, cpend); cvt_store(j.K, j.N, j.g, j.WT, j.mode, j.item, lane, cv); cpend = -1; }
        if (C.next < N_EXP_ITEMS) { const ExpJob j = exp_decode(C, C.next); cvt_load(j.W, j.N, j.item, lane, cv); cpend = C.next; C.next += C.stride; }
        if (cur <= jtw && !mydone) {
            f32x16 p0, p1; const f32x16 zero = f32x16{};
            qkt(p0, p1, shm + L_K + slot * SLOTB, qr, zero, r32, hi);
            float tot1, tot0;
            sb_half(p1, carry, tot1, hi, t, 64 * cur + 32);
            sb_half(p0, carry + tot1, tot0, hi, t, 64 * cur);
            carry += tot1 + tot0;
            u32x4 pw0 = (u32x4){PKW(p0, 0), PKW(p0, 2), PKW(p0, 4), PKW(p0, 6)}, pw1 = (u32x4){PKW(p0, 8), PKW(p0, 10), PKW(p0, 12), PKW(p0, 14)};
            u32x4 pw2 = (u32x4){PKW(p1, 0), PKW(p1, 2), PKW(p1, 4), PKW(p1, 6)}, pw3 = (u32x4){PKW(p1, 8), PKW(p1, 10), PKW(p1, 12), PKW(p1, 14)};
            SBAR();
            pv(o, vb0 + slot * SLOTB, __builtin_bit_cast(bf16x8, pw0), __builtin_bit_cast(bf16x8, pw1), __builtin_bit_cast(bf16x8, pw2), __builtin_bit_cast(bf16x8, pw3));
            mydone = __all(carry < -64.0f);
        }
        if (lane == 0) flags[(it & 1) * NWAVES + wid] = mydone ? 1 : 0;
        if (cur == 0) break;
        --cur; slot ^= 1; ++it;
    }
    if (cpend >= 0) { const ExpJob j = exp_decode(C, cpend); cvt_store(j.K, j.N, j.g, j.WT, j.mode, j.item, lane, cv); }
    float one[16];
#pragma unroll
    for (int r = 0; r < 16; ++r) one[r] = 1.0f;
    store_o(o, one, O + (rowbase + q0 + wid * 32) * DM + h * HD, shm, wid, lane, r32, hi);
    WAIT_BAR0();
}

__device__ const unsigned char T5B[128] = {0, 1, 2, 3, 4, 5, 6, 7, 8, 9, 10, 11, 12, 13, 14, 15, 16, 16, 16, 17, 17, 18, 18, 18, 19, 19, 19, 20, 20, 20, 20, 21, 21, 21, 21, 22, 22, 22, 22, 22, 23, 23, 23, 23, 23, 23,
    24, 24, 24, 24, 24, 24, 25, 25, 25, 25, 25, 25, 25, 26, 26, 26, 26, 26, 26, 26, 26, 27, 27, 27, 27, 27, 27, 27, 27, 27, 27, 28, 28, 28, 28, 28, 28, 28, 28, 28, 28, 29, 29, 29, 29, 29, 29, 29, 29, 29, 29, 29, 29,
    30, 30, 30, 30, 30, 30, 30, 30, 30, 30, 30, 30, 30, 30, 31, 31, 31, 31, 31, 31, 31, 31, 31, 31, 31, 31, 31, 31, 31};
__device__ __forceinline__ void moba_unit(int b, int h, int own, const bf16_t* Q, const bf16_t* K, const bf16_t* V, bf16_t* O, const float* km, const float* rel_bias, LAS char* shm) {
    int tid = threadIdx.x; asm volatile("" : "+v"(tid));
    const int lane = tid & 63, r32 = lane & 31, hi = lane >> 5; const int wid = __builtin_amdgcn_readfirstlane(tid >> 6);
    const size_t rowbase = (size_t)b * SEQ; const int q0 = own * 256;
    const bf16_t* Qw = Q + (rowbase + q0 + wid * 32) * DM + h * HD;
    const bf16_t* Kh = K + rowbase * DM + h * HD; const bf16_t* Vh = V + rowbase * DM + h * HD;
    const unsigned lds0 = (unsigned)(uintptr_t)shm;
    const bf16_t* ksrc = Kh + (size_t)lane * DM + wid * 8;
    const bf16_t* vsrc = Vh + (size_t)(16 * (wid & 3) + (lane >> 2)) * DM + (wid >> 2) * 32 + (lane & 3) * 8;
    const unsigned kdst = lds0 + L_K + wid * 1024, vdst = lds0 + L_V + wid * 1024;
    const int vb0 = (int)(lds0 + L_V) + ((lane >> 4) & 1) * 32 + (lane & 3) * 8 + (4 * hi + ((lane & 15) >> 2)) * 64;
    LAS float* wsf = (LAS float*)(shm + L_WS) + wid * 64;
    LAS float* kmL = (LAS float*)(shm + L_TAB);
    LAS float* dlL = kmL + 512;
    kmL[tid] = km[(size_t)(b * NH + h) * 512 + tid];
    if (tid < 128) dlL[tid] = (rel_bias[(int)T5B[tid] * NH + h] - rel_bias[31 * NH + h]) * LOG2E;
    const int NT = 4 * own + 4;
    glds16(ksrc, (unsigned)__builtin_amdgcn_readfirstlane(kdst));
    glds16(vsrc, (unsigned)__builtin_amdgcn_readfirstlane(vdst));
    bf16x8 qr[4];
#pragma unroll
    for (int d0 = 0; d0 < 4; ++d0) qr[d0] = *(const bf16x8*)(Qw + (size_t)r32 * DM + d0 * 16 + hi * 8);
    WAIT_BAR0();
    unsigned sel = 0;
    {
        float gp[8];
#pragma unroll
        for (int n = 0; n < 8; ++n) gp[n] = 0.f;
#pragma unroll
        for (int d0 = 0; d0 < 4; ++d0)
#pragma unroll
            for (int n = 0; n < 8; ++n) { const LAS f32x4* kp = (const LAS f32x4*)(kmL + n * 64 + d0 * 16 + hi * 8); const f32x4 k0 = kp[0], k1 = kp[1];
                gp[n] += bf2f((unsigned short)qr[d0][0]) * k0[0] + bf2f((unsigned short)qr[d0][1]) * k0[1] + bf2f((unsigned short)qr[d0][2]) * k0[2] + bf2f((unsigned short)qr[d0][3]) * k0[3]
                       + bf2f((unsigned short)qr[d0][4]) * k1[0] + bf2f((unsigned short)qr[d0][5]) * k1[1] + bf2f((unsigned short)qr[d0][6]) * k1[2] + bf2f((unsigned short)qr[d0][7]) * k1[3]; }
        float gt[8];
#pragma unroll
        for (int n = 0; n < 8; ++n) gt[n] = swap_sum(gp[n]);
#pragma unroll
        for (int n = 0; n < 8; ++n) { int rank = 0;
#pragma unroll
            for (int m2 = 0; m2 < 8; ++m2) if (m2 != n) rank += (m2 < own && (gt[m2] > gt[n] || (gt[m2] == gt[n] && m2 < n))) ? 1 : 0;
            if (n < own && rank < 3) sel |= 1u << n; }
    }
    const int t = q0 + wid * 32 + r32;
    f32x16 o[2]; o[0] = f32x16{}; o[1] = f32x16{};
    float m_run = -1e30f, l_run = 0.f;
    for (int tt = 0; tt < NT; ++tt) {
        const int slot = tt & 1;
        if (tt > 0) WAIT_BAR0();
        if (tt + 1 < NT) { glds16(ksrc + (size_t)(tt + 1) * 64 * DM, (unsigned)__builtin_amdgcn_readfirstlane(kdst + (slot ^ 1) * SLOTB));
                           glds16(vsrc + (size_t)(tt + 1) * 64 * DM, (unsigned)__builtin_amdgcn_readfirstlane(vdst + (slot ^ 1) * SLOTB)); }
        const int n = tt >> 2; const bool ownb = (n == own); const int key0 = 64 * tt;
        if (ownb && key0 > q0 + wid * 32 + 31) continue;
        const bool lsel = ownb || ((sel >> n) & 1u);
        f32x16 c0; { const float cv = lsel ? 0.f : -INFINITY;
#pragma unroll
            for (int r = 0; r < 16; ++r) c0[r] = cv; }
        f32x16 p0, p1;
        qkt(p0, p1, shm + L_K + slot * SLOTB, qr, c0, r32, hi);
        if (key0 + 63 + 127 >= q0 + wid * 32) {
#pragma unroll
            for (int r = 0; r < 16; ++r) { const int d0 = t - (key0 + crow(r, hi)), d1 = d0 - 32;
                if (d0 < 0) p0[r] = -INFINITY; else if (d0 < 128) p0[r] += dlL[d0];
                if (d1 < 0) p1[r] = -INFINITY; else if (d1 < 128) p1[r] += dlL[d1]; }
        }
        float mx = p0[0];
#pragma unroll
        for (int r = 1; r < 16; ++r) mx = __builtin_fmaxf(mx, p0[r]);
#pragma unroll
        for (int r = 0; r < 16; ++r) mx = __builtin_fmaxf(mx, p1[r]);
        mx = swap_max(mx);
        const float m_new = __builtin_fmaxf(m_run, mx);
        const float alpha = __builtin_amdgcn_exp2f(m_run - m_new);
        m_run = m_new;
        float ls = 0.f;
#pragma unroll
        for (int r = 0; r < 16; ++r) { p0[r] = __builtin_amdgcn_exp2f(p0[r] - m_new); ls += p0[r]; }
#pragma unroll
        for (int r = 0; r < 16; ++r) { p1[r] = __builtin_amdgcn_exp2f(p1[r] - m_new); ls += p1[r]; }
        l_run = l_run * alpha + ls;
        if (__any(alpha != 1.0f)) {
            if (hi == 0) wsf[r32] = alpha;
            asm volatile("s_waitcnt lgkmcnt(0)" ::: "memory");
#pragma unroll
            for (int r = 0; r < 16; ++r) { const float f = wsf[crow(r, hi)]; o[0][r] *= f; o[1][r] *= f; }
        }
        u32x4 pw0 = (u32x4){PKW(p0, 0), PKW(p0, 2), PKW(p0, 4), PKW(p0, 6)}, pw1 = (u32x4){PKW(p0, 8), PKW(p0, 10), PKW(p0, 12), PKW(p0, 14)};
        u32x4 pw2 = (u32x4){PKW(p1, 0), PKW(p1, 2), PKW(p1, 4), PKW(p1, 6)}, pw3 = (u32x4){PKW(p1, 8), PKW(p1, 10), PKW(p1, 12), PKW(p1, 14)};
        SBAR();
        pv(o, vb0 + slot * SLOTB, __builtin_bit_cast(bf16x8, pw0), __builtin_bit_cast(bf16x8, pw1), __builtin_bit_cast(bf16x8, pw2), __builtin_bit_cast(bf16x8, pw3));
    }
    const float lt = swap_sum(l_run);
    if (hi == 0) wsf[32 + r32] = lt;
    asm volatile("s_waitcnt lgkmcnt(0)" ::: "memory");
    float rli[16];
#pragma unroll
    for (int r = 0; r < 16; ++r) rli[r] = __builtin_amdgcn_rcpf(wsf[32 + crow(r, hi)]);
    store_o(o, rli, O + (rowbase + q0 + wid * 32) * DM + h * HD, shm, wid, lane, r32, hi);
    WAIT_BAR0();
}

#undef PKW
__device__ __forceinline__ float max3f(float a,float b,float c){float r;asm("v_max3_f32 %0, %1, %2, %3":"=v"(r):"v"(a),"v"(b),"v"(c));return r;}
__device__ __forceinline__ float max2f(float a,float b){float r;asm("v_max_f32_e32 %0, %1, %2":"=v"(r):"v"(a),"v"(b));return r;}
__device__ __forceinline__ float fadd_s(float a,float b){float r;asm("v_add_f32_e32 %0, %1, %2":"=v"(r):"v"(a),"v"(b));return r;}
__device__ __forceinline__ float fsub_s(float a,float b){float r;asm("v_sub_f32_e32 %0, %1, %2":"=v"(r):"v"(a),"v"(b));return r;}
#define WAIT_BAR(N) asm volatile("s_waitcnt vmcnt(" #N ") lgkmcnt(0)\n\ts_barrier":::"memory")
typedef LAS const char* lds_cptr;
__device__ __forceinline__ void kload8(bf16x8*kf,lds_cptr kp){
  kf[0]=*(const LAS bf16x8*)(kp);      kf[1]=*(const LAS bf16x8*)(kp+512);
  kf[2]=*(const LAS bf16x8*)(kp+2048); kf[3]=*(const LAS bf16x8*)(kp+2560);
  kf[4]=*(const LAS bf16x8*)(kp+4096); kf[5]=*(const LAS bf16x8*)(kp+4608);
  kf[6]=*(const LAS bf16x8*)(kp+6144); kf[7]=*(const LAS bf16x8*)(kp+6656);
}
__device__ __forceinline__ void kload2(bf16x8*kf,lds_cptr kp,int j){ kf[2*j]=*(const LAS bf16x8*)(kp+j*2048); kf[2*j+1]=*(const LAS bf16x8*)(kp+j*2048+512); }
__device__ __forceinline__ s16x4 vtr(lds_cptr p){ return __builtin_bit_cast(s16x4,__builtin_amdgcn_ds_read_tr16_b64_v4i16((LAS v4i16_t*)p)); }
__device__ __forceinline__ float rowmax(const f32x16&p0,const f32x16&p1){
  float a=max3f(p0[0],p0[1],p1[0]),b=max3f(p0[2],p0[3],p1[1]);a=max3f(a,p1[2],p1[3]);
  #pragma unroll
  for(int r=4;r<16;r+=4){a=max3f(a,p0[r],p0[r+1]);b=max3f(b,p0[r+2],p0[r+3]);a=max3f(a,p1[r],p1[r+1]);b=max3f(b,p1[r+2],p1[r+3]);}
  const float m=max2f(a,b);
  auto rr=__builtin_amdgcn_permlane32_swap(__float_as_uint(m),__float_as_uint(m),false,false);
  return max2f(__uint_as_float(rr[0]),__uint_as_float(rr[1]));
}
__device__ __forceinline__ void bmask(f32x16&p0,f32x16&p1,int tile,int tq,int hi,const LAS float*dl){
  const int kb=64*tile+4*hi;
  #pragma unroll
  for(int r=0;r<16;++r){ const int d0=tq-(kb+(r&3)+8*(r>>2)), d1=d0-32;
    if(d0<0)p0[r]=-INFINITY; else if(d0<128)p0[r]+=dl[d0];
    if(d1<0)p1[r]=-INFINITY; else if(d1<128)p1[r]+=dl[d1]; }
}
template<int THRL> __device__ __forceinline__ void moba_fast(int b,int h,int qb,const bf16_t*Q,const bf16_t*__restrict__ K,const bf16_t*__restrict__ V,bf16_t*O,const float*km,const float*rel_bias,LAS char*shm){
  int tid=threadIdx.x; asm volatile("":"+v"(tid));
  const int lane=tid&63,r32=lane&31,hi=lane>>5; const int wid=__builtin_amdgcn_readfirstlane(tid>>6);
  const int own=qb;
  LAS float*kmL=(LAS float*)(shm+L_TAB); LAS float*dlL=kmL+512;
  { const float kv_=km[(size_t)(b*NH+h)*512+tid]; float dv_=0.f; if(tid<128)dv_=(rel_bias[(int)T5B[tid]*NH+h]-rel_bias[31*NH+h])*LOG2E; kmL[tid]=kv_; if(tid<128)dlL[tid]=dv_; }
  const long rowbase=(long)b*SEQ; const int q0=qb*256;
  const bf16_t*Qw=Q+(rowbase+q0+wid*32)*DM+h*HD;
  const bf16_t*Kh=K+rowbase*DM+h*HD,*Vh=V+rowbase*DM+h*HD;
  const unsigned lds0=(unsigned)(uintptr_t)shm;
  LAS float*wsf=(LAS float*)(shm+L_WS)+wid*64;
  const bf16_t*ksrc=Kh+(long)lane*DM+wid*8;
  const bf16_t*vsrc=Vh+(long)(16*(wid&3)+(lane>>2))*DM+(wid>>2)*32+(lane&3)*8;
  const unsigned kdst=lds0+L_K+wid*1024, vdst=lds0+L_V+wid*1024;
  #define DMA_K(t,slot) glds16(ksrc+(long)(t)*64*DM,(unsigned)__builtin_amdgcn_readfirstlane(kdst+(slot)))
  #define DMA_V(t,slot) glds16(vsrc+(long)(t)*64*DM,(unsigned)__builtin_amdgcn_readfirstlane(vdst+(slot)))
  const int vb0=(int)(lds0+L_V)+((lane>>4)&1)*32+(lane&3)*8+(4*hi+((lane&15)>>2))*64;
  const LAS char*Kbase=shm+L_K; bf16x8 kf[8];
  const lds_cptr shm3=(lds_cptr)shm; const lds_cptr kp0=shm3+L_K+hi*1024+r32*16; const lds_cptr vp0=shm3+L_V+((lane>>4)&1)*32+(lane&3)*8+(4*hi+((lane&15)>>2))*64;
  const int NT=(q0+256)/64;
  DMA_K(0,0);DMA_V(0,0);DMA_K(1,SLOTB);
  bf16x8 qr[4];
  #pragma unroll
  for(int d0=0;d0<4;++d0)qr[d0]=*reinterpret_cast<const bf16x8*>(&Qw[(long)r32*DM+d0*16+hi*8]);
  const int tq=q0+wid*32+r32;
  float mhat=0.f,l_reg=0.f,negsel=0.f;f32x16 o[2];o[0]=f32x16{};o[1]=f32x16{};f32x16 negm=f32x16{};asm volatile("":"+v"(negm));
  unsigned sel=0u; bool seen=false;
  #define SETSEL(n) do{ negsel=((n)==own||((sel>>(n))&1u))?0.f:-1e30f; const float nm_=negsel-mhat; _Pragma("unroll") for(int r=0;r<16;++r)negm[r]=nm_; asm volatile("":"+v"(negm)); }while(0)
  #define CMASK(P0,P1,t) do{ if(64*(t)+63+127>=q0+wid*32) bmask(P0,P1,(t),tq,hi,dlL); }while(0)
  bool resc=false;
  #define START(P0,P1) do{ const float rm=rowmax(P0,P1); resc=false; seen=rm>-1e29f; \
    { const float dl=seen?rm:0.f; mhat=fadd_s(mhat,dl); \
      _Pragma("unroll") for(int r=0;r<16;++r){P0[r]=fsub_s(P0[r],dl);P1[r]=fsub_s(P1[r],dl);} \
      { const float nm_=negsel-mhat; _Pragma("unroll") for(int r=0;r<16;++r)negm[r]=nm_; } asm volatile("":"+v"(negm)); } \
    _Pragma("unroll") for(int r=0;r<16;++r)P0[r]=__builtin_amdgcn_exp2f(P0[r]); }while(0)
  #define RESC() do{ if(resc){ asm volatile("s_waitcnt lgkmcnt(0)":::"memory"); \
      _Pragma("unroll") for(int d_=0;d_<2;++d_) _Pragma("unroll") for(int r=0;r<16;++r)o[d_][r]*=wsf[crow(r,hi)]; } }while(0)
  f32x16 pA0,pA1,pB0,pB1;
  int sl_prev=0,sl_cur=0,sl_next=SLOTB;
  #define ROT() do{sl_prev=sl_cur;sl_cur=sl_next;sl_next=(sl_next==(NSLOT-1)*SLOTB)?0:sl_next+SLOTB;}while(0)
  DMA_K(2,2*SLOTB);
  WAIT_BAR(3);
  { float gp[8];
    #pragma unroll
    for(int n=0;n<8;++n)gp[n]=0.f;
    #pragma unroll
    for(int d0=0;d0<4;++d0){
      #pragma unroll
      for(int n=0;n<8;++n){ const LAS f32x4*kp=(const LAS f32x4*)(kmL+n*64+d0*16+hi*8); const f32x4 k0=kp[0],k1=kp[1];
        gp[n]+=bf2f((unsigned short)qr[d0][0])*k0[0]+bf2f((unsigned short)qr[d0][1])*k0[1]+bf2f((unsigned short)qr[d0][2])*k0[2]+bf2f((unsigned short)qr[d0][3])*k0[3]
              +bf2f((unsigned short)qr[d0][4])*k1[0]+bf2f((unsigned short)qr[d0][5])*k1[1]+bf2f((unsigned short)qr[d0][6])*k1[2]+bf2f((unsigned short)qr[d0][7])*k1[3]; } }
    float gt[8];
    #pragma unroll
    for(int n=0;n<8;++n)gt[n]=swap_sum(gp[n]);
    #pragma unroll
    for(int n=0;n<8;++n){ int rank=0;
      #pragma unroll
      for(int m2=0;m2<8;++m2) if(m2!=n) rank+=(m2<own&&(gt[m2]>gt[n]||(gt[m2]==gt[n]&&m2<n)))?1:0;
      if(n<own&&rank<3)sel|=1u<<n; } }
  SETSEL(0);
  qkt(pA0,pA1,Kbase,qr,negm,r32,hi);asm volatile("s_nop 15\n\ts_nop 7":"+v"(pA0),"+v"(pA1));CMASK(pA0,pA1,0);
  START(pA0,pA1);
  _Pragma("unroll") for(int r=0;r<16;++r)pA1[r]=__builtin_amdgcn_exp2f(pA1[r]);
  WAIT_BAR(0);
  DMA_K(3,0);DMA_V(1,SLOTB);
  ROT();
  kload8(kf,kp0+sl_cur);
  WAIT_BAR(2);
  s16x4 vlo[8],vhi[8]; u32x4 pw0,pw1,pw2,pw3;
  #define PKW(P,B) cvtpk(P[B],P[B+1])
  #define PAF(k) __builtin_bit_cast(bf16x8,pw##k)
  #define VFR(i) (bf16x8){vlo[i][0],vlo[i][1],vlo[i][2],vlo[i][3],vhi[i][0],vhi[i][1],vhi[i][2],vhi[i][3]}
  #define PIN(x) asm volatile("":"+v"(x))
  #define MX3(a,b,c) __builtin_fmaxf(__builtin_fmaxf((a),(b)),(c))
  #define GAPA(MF,A0,A1,A2,A3,W0,W1,PW) do{ MF; sacc+=A0; sacc+=A1; sacc+=A2; sacc+=A3; PIN(sacc); W0; W1; PIN(PW); SBAR(); }while(0)
  #define EX(v) __builtin_amdgcn_exp2f(v)
  #define GAPB(MF,X,B) do{ MF; X[B]=EX(X[B]); X[B+1]=EX(X[B+1]); X[B+2]=EX(X[B+2]); X[B+3]=EX(X[B+3]); PIN(X); SBAR(); }while(0)
  #define VRD(i) do{ vlo[i]=vtr(vp_+(((i)>>2)*4096+((i)&3)*1024)); vhi[i]=vtr(vp_+(((i)>>2)*4096+((i)&3)*1024+512)); }while(0)
  #define KRD(G,j) do{ if(G){ kload2(kf,kp0+sl_next,j); SBAR(); } }while(0)
  #define STEP(C0,C1,P0,P1,t,GK,GV,GL) do{ SBAR(); \
    const lds_cptr vp_=vp0+sl_prev; \
    VRD(0); SBAR(); float sacc=(P0[0]+P0[1]); \
    GAPA(C0=__builtin_amdgcn_mfma_f32_32x32x16_bf16(kf[0],qr[0],negm,0,0,0), P0[2],P0[3],P0[4],P0[5],     pw0[0]=PKW(P0,0), pw0[1]=PKW(P0,2), pw0); \
    VRD(4); SBAR(); GAPA(C1=__builtin_amdgcn_mfma_f32_32x32x16_bf16(kf[1],qr[0],negm,0,0,0), P0[6],P0[7],P0[8],P0[9],     pw0[2]=PKW(P0,4), pw0[3]=PKW(P0,6), pw0); \
    VRD(1); SBAR(); GAPA(C0=__builtin_amdgcn_mfma_f32_32x32x16_bf16(kf[2],qr[1],C0,0,0,0),   P0[10],P0[11],P0[12],P0[13], pw1[0]=PKW(P0,8), pw1[1]=PKW(P0,10), pw1); \
    VRD(5); SBAR(); GAPA(C1=__builtin_amdgcn_mfma_f32_32x32x16_bf16(kf[3],qr[1],C1,0,0,0),   P0[14],P0[15],P1[0],P1[1],   pw1[2]=PKW(P0,12),pw1[3]=PKW(P0,14), pw1); \
    VRD(2); SBAR(); GAPA(C0=__builtin_amdgcn_mfma_f32_32x32x16_bf16(kf[4],qr[2],C0,0,0,0),   P1[2],P1[3],P1[4],P1[5],     pw2[0]=PKW(P1,0), pw2[1]=PKW(P1,2), pw2); \
    VRD(6); SBAR(); GAPA(C1=__builtin_amdgcn_mfma_f32_32x32x16_bf16(kf[5],qr[2],C1,0,0,0),   P1[6],P1[7],P1[8],P1[9],     pw2[2]=PKW(P1,4), pw2[3]=PKW(P1,6), pw2); \
    VRD(3); SBAR(); GAPA(C0=__builtin_amdgcn_mfma_f32_32x32x16_bf16(kf[6],qr[3],C0,0,0,0),   P1[10],P1[11],P1[12],P1[13], pw3[0]=PKW(P1,8), pw3[1]=PKW(P1,10), pw3); \
    VRD(7); SBAR(); GAPA(C1=__builtin_amdgcn_mfma_f32_32x32x16_bf16(kf[7],qr[3],C1,0,0,0),   P1[14],P1[15],0.f,0.f,       pw3[2]=PKW(P1,12),pw3[3]=PKW(P1,14), pw3); \
    l_reg+=sacc; \
    if(GK){DMA_K((t)+3,sl_cur);} if(GV){DMA_V((t)+1,sl_next);} \
    CMASK(C0,C1,t); \
    { float a=MX3(C0[0],C0[1],C1[0]),b=MX3(C0[2],C0[3],C1[1]); a=MX3(a,C1[2],C1[3]); \
      _Pragma("unroll") for(int r=4;r<16;r+=4){a=MX3(a,C0[r],C0[r+1]);b=MX3(b,C0[r+2],C0[r+3]);a=MX3(a,C1[r],C1[r+1]);b=MX3(b,C1[r+2],C1[r+3]);} \
      float rm=__builtin_fmaxf(a,b); { auto rr=__builtin_amdgcn_permlane32_swap(__float_as_uint(rm),__float_as_uint(rm),false,false); rm=__builtin_fmaxf(__uint_as_float(rr[0]),__uint_as_float(rr[1])); } \
      resc=false; const bool real_=rm>-1e29f; const bool fst_=(!seen)&&real_&&(rm<-(float)THRL); \
      if(__builtin_expect(__any(rm>(float)THRL||fst_),0)){ const float dl=fst_?rm:__builtin_fmaxf(rm,0.f); mhat+=dl; \
        _Pragma("unroll") for(int r=0;r<16;++r){C0[r]-=dl;C1[r]-=dl;} \
        { const float nm_=negsel-mhat; _Pragma("unroll") for(int r=0;r<16;++r)negm[r]=nm_; } asm volatile("":"+v"(negm)); \
        const float f=seen?__builtin_amdgcn_exp2f(-dl):1.f; l_reg*=f; if(hi==0)wsf[r32]=f; resc=true; } seen=seen||real_; } \
    SBAR(); \
    GAPB(o[0]=__builtin_amdgcn_mfma_f32_32x32x16_bf16(PAF(0),VFR(0),o[0],0,0,0), C0,0); \
    GAPB(o[1]=__builtin_amdgcn_mfma_f32_32x32x16_bf16(PAF(0),VFR(4),o[1],0,0,0), C0,4); \
    KRD(GL,0); GAPB(o[0]=__builtin_amdgcn_mfma_f32_32x32x16_bf16(PAF(1),VFR(1),o[0],0,0,0), C0,8); \
    KRD(GL,1); GAPB(o[1]=__builtin_amdgcn_mfma_f32_32x32x16_bf16(PAF(1),VFR(5),o[1],0,0,0), C0,12); \
    KRD(GL,2); GAPB(o[0]=__builtin_amdgcn_mfma_f32_32x32x16_bf16(PAF(2),VFR(2),o[0],0,0,0), C1,0); \
    KRD(GL,3); GAPB(o[1]=__builtin_amdgcn_mfma_f32_32x32x16_bf16(PAF(2),VFR(6),o[1],0,0,0), C1,4); \
    GAPB(o[0]=__builtin_amdgcn_mfma_f32_32x32x16_bf16(PAF(3),VFR(3),o[0],0,0,0), C1,8); \
    GAPB(o[1]=__builtin_amdgcn_mfma_f32_32x32x16_bf16(PAF(3),VFR(7),o[1],0,0,0), C1,12); \
    }while(0)
  int t=1;
  #undef CMASK
  #define CMASK(P0,P1,t) do{}while(0)
  for(;t+7<NT;t+=2){
    STEP(pB0,pB1,pA0,pA1,t,true,true,true);     WAIT_BAR(2); RESC(); ROT();
    if(((t+1)&3)==0)SETSEL((t+1)>>2);
    STEP(pA0,pA1,pB0,pB1,t+1,true,true,true);   WAIT_BAR(2); RESC(); ROT();
  }
  #undef CMASK
  #define CMASK(P0,P1,t) do{ if(64*(t)+63+127>=q0+wid*32) bmask(P0,P1,(t),tq,hi,dlL); }while(0)
  #define ENDW(tt) do{ if((tt)+3<NT){WAIT_BAR(2);} else if((tt)+2<NT){WAIT_BAR(1);} else {WAIT_BAR(0);} }while(0)
  for(;t+1<NT;t+=2){
    STEP(pB0,pB1,pA0,pA1,t,(t+3<NT),(t+1<NT),(t+1<NT));       ENDW(t);   RESC(); ROT();
    if(((t+1)&3)==0)SETSEL((t+1)>>2);
    STEP(pA0,pA1,pB0,pB1,t+1,(t+4<NT),(t+2<NT),(t+2<NT));     ENDW(t+1); RESC(); ROT();
  }
  STEP(pB0,pB1,pA0,pA1,NT-1,false,false,false); RESC();
  { float sacc=pB0[0]+pB0[1]; _Pragma("unroll") for(int r=2;r<16;++r)sacc+=pB0[r]; _Pragma("unroll") for(int r=0;r<16;++r)sacc+=pB1[r]; l_reg+=sacc;
    pw0=(u32x4){PKW(pB0,0),PKW(pB0,2),PKW(pB0,4),PKW(pB0,6)};pw1=(u32x4){PKW(pB0,8),PKW(pB0,10),PKW(pB0,12),PKW(pB0,14)};pw2=(u32x4){PKW(pB1,0),PKW(pB1,2),PKW(pB1,4),PKW(pB1,6)};pw3=(u32x4){PKW(pB1,8),PKW(pB1,10),PKW(pB1,12),PKW(pB1,14)};
    SBAR(); pv(o,vb0+sl_cur,PAF(0),PAF(1),PAF(2),PAF(3)); }
  #undef PKW
  #undef PAF
  #undef VFR
  #undef PIN
  #undef MX3
  #undef GAPA
  #undef GAPB
  #undef EX
  #undef VRD
  #undef KRD
  #undef STEP
  #undef ENDW
  {auto rr=__builtin_amdgcn_permlane32_swap(__float_as_uint(l_reg),__float_as_uint(l_reg),false,false);l_reg=__uint_as_float(rr[0])+__uint_as_float(rr[1]);}
  if(hi==0)wsf[32+r32]=l_reg;asm volatile("s_waitcnt lgkmcnt(0)":::"memory");
  float rli[16];
  #pragma unroll
  for(int r=0;r<16;++r)rli[r]=__builtin_amdgcn_rcpf(wsf[32+crow(r,hi)]);
  bf16_t*Ow=O+(rowbase+q0+wid*32)*DM+h*HD;
  { LAS bf16_t*stg=(LAS bf16_t*)(shm+L_OST)+wid*2048;
    #pragma unroll
    for(int r=0;r<16;++r){const int orow=crow(r,hi);
      #pragma unroll
      for(int d0=0;d0<2;++d0)stg[orow*64+d0*32+r32]=(bf16_t)(cvtpk(o[d0][r]*rli[r],0.f)&0xffffu);}
    asm volatile("s_waitcnt lgkmcnt(0)":::"memory");
    #pragma unroll
    for(int i=0;i<4;++i){const int row=i*8+(lane>>3),ch=lane&7; const u32x4 v=*(const LAS u32x4*)(stg+row*64+ch*8); *(u32x4*)(Ow+(long)row*DM+ch*8)=v;} }
  asm volatile("s_waitcnt lgkmcnt(0)\n\ts_barrier":::"memory");
  #undef DMA_K
  #undef DMA_V
  #undef CMASK
  #undef START
  #undef RESC
  #undef ROT
  #undef SETSEL
}
#undef WAIT_BAR
#undef SBAR
#undef WAIT_BAR0
}

constexpr size_t MiB = 1u << 20, KiB = 1u << 10;
constexpr size_t WS_CTL = 0, CTL_ZERO_BYTES = 1 * MiB;
constexpr size_t WS_SSP = 1 * MiB;
constexpr size_t WS_TAB = 2 * MiB;
constexpr size_t WS_TOKE = WS_TAB, WS_TOKG = WS_TAB + 128 * KiB, WS_TOKS = WS_TAB + 256 * KiB, WS_RSTD = WS_TAB + 384 * KiB;
constexpr size_t WS_ROWIDX = WS_TAB + 448 * KiB, WS_RSLOT = WS_TAB + 592 * KiB;
constexpr size_t WS_HIST = WS_TAB + 736 * KiB, WS_TILEE = WS_TAB + 744 * KiB, WS_NTIL = WS_TAB + 745 * KiB, WS_KM = WS_TAB + 768 * KiB;
constexpr size_t WS_E13 = 4 * MiB, WS_E2 = 116 * MiB, WS_HB = 172 * MiB, WS_SW = 204 * MiB;
constexpr size_t WS_WQKV0 = WS_SW, WS_WQKV1 = WS_SW + 6 * MiB, WS_WO0 = WS_SW + 12 * MiB, WS_WO1 = WS_SW + 14 * MiB, WS_W13 = WS_SW + 16 * MiB, WS_W2 = WS_SW + 27 * MiB;
constexpr size_t WS_QO = 237 * MiB, WS_K = 269 * MiB, WS_V = 301 * MiB, WS_HID0 = 237 * MiB;
constexpr size_t WS_H = 204 * MiB;
constexpr size_t WS_Y = 4 * MiB;
constexpr size_t WS_END = 441 * MiB;
static_assert(MAXSLOT * 4 <= 144 * KiB && WS_KM + 128 * 8 * 64 * 4 <= WS_E13, "tables");
static_assert(WS_W2 + (size_t)DM * FF * 2 <= WS_QO && WS_W13 + (size_t)2 * FF * DM * 2 <= WS_W2, "small weights");
static_assert(WS_HID0 + (size_t)M * FF * 2 <= WS_END && WS_H + (size_t)MAXSLOT * FE * 2 <= WS_END && WS_Y + (size_t)MAXSLOT * DM * 2 <= WS_E2, "overlays");
static_assert(WS_E13 + (size_t)NE * 2 * FE * DM * 2 <= WS_E2 && WS_E2 + (size_t)NE * DM * FE * 2 <= WS_HB && WS_HB + (size_t)M * DM * 2 <= WS_SW, "expert weights");
constexpr int CW_TMO = 0, CW_CODE = 1, CW_BAR = 4096;

constexpr int RING_OFF = 0, RING_BYTES = 131072;
constexpr int LDSCTL_OFF = RING_BYTES, MISC_OFF = LDSCTL_OFF + 320;
constexpr int LDS_BYTES = 147456;
static_assert(att::L_BYTES <= RING_BYTES && MISC_OFF + 128 <= LDS_BYTES, "LDS map");

#define XB_TMO      128
#define XB_XCNT(j)  (256  + 64 * (j))
#define XB_XSUB(j)  (1280 + 64 * (j))
#define XB_XGEN(j)  (2304 + 64 * (j))
#define XB_TOP      3328
#define XB_TOPGEN   3392
#define XCD_BAR_WORDS 3456
#define XB_SPIN_CAP (1u << 18)
__device__ __forceinline__ unsigned xb_ld(unsigned* p)              { return __hip_atomic_load(p, __ATOMIC_RELAXED, __HIP_MEMORY_SCOPE_AGENT); }
__device__ __forceinline__ unsigned xb_add(unsigned* p, unsigned v) { return __hip_atomic_fetch_add(p, v, __ATOMIC_RELAXED, __HIP_MEMORY_SCOPE_AGENT); }
__device__ __forceinline__ unsigned xb_xcc_id() { return (unsigned)__builtin_amdgcn_s_getreg((3 << 11) | 20) & 0xFu; }
#define XB_SPIN(cond, bar) do { unsigned _sp = 0; while (cond) { __builtin_amdgcn_s_sleep(1); \
    if ((++_sp & 255u) == 0u) { if (xb_ld(&(bar)[XB_TMO])) break; if (_sp > XB_SPIN_CAP) { atomicAdd(&(bar)[XB_TMO], 1u); break; } } } } while (0)
struct XcdBarrier { unsigned* bar; unsigned x; volatile LAS unsigned* st; };
__device__ __forceinline__ XcdBarrier xcd_barrier_post(unsigned* bar, volatile LAS unsigned* st) {
    XcdBarrier b; b.bar = bar; b.x = xb_xcc_id(); b.st = st;
    if (threadIdx.x == 0) (void)xb_add(&bar[XB_XCNT(b.x)], 1u);
    return b;
}
__device__ __forceinline__ void xcd_barrier_complete(unsigned* bar, unsigned x, unsigned& nloc, unsigned& nx) {
    const unsigned G = gridDim.x * gridDim.y * gridDim.z;
    unsigned sum, cnt, mine, sp = 0u;
    for (;;) {
        sum = 0u; cnt = 0u; mine = 0u;
#pragma unroll
        for (unsigned j = 0; j < 16; ++j) { const unsigned c = xb_ld(&bar[XB_XCNT(j)]); sum += c; cnt += (c > 0u) ? 1u : 0u; mine = (j == x) ? c : mine; }
        if (sum == G) break;
        __builtin_amdgcn_s_sleep(1);
        if ((++sp & 255u) == 0u) { if (xb_ld(&bar[XB_TMO])) break; if (sp > XB_SPIN_CAP) { atomicAdd(&bar[XB_TMO], 1u); break; } }
    }
    nloc = mine > 0u ? mine : 1u; nx = cnt > 0u ? cnt : 1u;
}
__device__ __forceinline__ void xcd_barrier(const XcdBarrier& b) {
    asm volatile("s_waitcnt vmcnt(0)" ::: "memory");
    __syncthreads();
    if (threadIdx.x == 0) {
        unsigned* bar = b.bar;
        __builtin_amdgcn_s_waitcnt(0);
        unsigned nloc = b.st[0], nx = b.st[1];
        if (nloc == 0u) { xcd_barrier_complete(bar, b.x, nloc, nx); b.st[0] = nloc; b.st[1] = nx; }
        const unsigned old = xb_add(&bar[XB_XSUB(b.x)], 1u);
        const unsigned gen = old / nloc;
        if (old + 1u == (gen + 1u) * nloc) {
            __builtin_amdgcn_fence(__ATOMIC_RELEASE, "agent");
            asm volatile("s_waitcnt vmcnt(0)" ::: "memory");
            const unsigned og = xb_add(&bar[XB_TOP], 1u);
            const unsigned tg = og / nx;
            if (og + 1u == (tg + 1u) * nx) xb_add(&bar[XB_TOPGEN], 1u);
            else XB_SPIN(xb_ld(&bar[XB_TOPGEN]) == tg, bar);
            __builtin_amdgcn_fence(__ATOMIC_ACQUIRE, "agent");
            xb_add(&bar[XB_XGEN(b.x)], 1u);
            asm volatile("s_waitcnt vmcnt(0)" ::: "memory");
        } else {
            XB_SPIN(xb_ld(&bar[XB_XGEN(b.x)]) == gen, bar);
            __builtin_amdgcn_fence(__ATOMIC_ACQUIRE, "agent");
            asm volatile("s_waitcnt vmcnt(0)" ::: "memory");
        }
    }
    __syncthreads();
}

struct Args { const float* in[14]; float* out; unsigned char* ws; };
struct Frame { LAS unsigned char* lds; int tid, lane, wave, vcu, G; };

__device__ __forceinline__ void p0_prologue(const Frame& F, const Args& a) {
    unsigned char* ws = a.ws;
    const float* w_qkv = a.in[1]; const float* w_o = a.in[2]; const float* mixer_norm = a.in[3]; const float* ffn_norm = a.in[4];
    const float* w1 = a.in[6]; const float* w3 = a.in[7]; const float* w2 = a.in[8];
    const int gw = F.vcu * NWAVES + F.wave, NGW = F.G * NWAVES;
    constexpr int I_QKV = 16 * 96, I_O = 16 * 32, I_13 = 16 * 88, I_2 = 44 * 32;
    constexpr int NITEMS = 2 * I_QKV + 2 * I_O + 2 * I_13 + I_2;
    for (int it = gw; it < NITEMS; it += NGW) {
        int r = it;
        if (r < 2 * I_QKV) { const int l = r / I_QKV; r -= l * I_QKV; cvt_item(w_qkv + (size_t)l * DM * NQKV, DM, NQKV, mixer_norm + l * DM, (bf16_t*)(ws + (l ? WS_WQKV1 : WS_WQKV0)), 0, r, F.lane); continue; } r -= 2 * I_QKV;
        if (r < 2 * I_O) { const int l = r / I_O; r -= l * I_O; cvt_item(w_o + (size_t)l * DM * DM, DM, DM, nullptr, (bf16_t*)(ws + (l ? WS_WO1 : WS_WO0)), 0, r, F.lane); continue; } r -= 2 * I_O;
        if (r < I_13) { cvt_item(w1, DM, FF, ffn_norm, (bf16_t*)(ws + WS_W13), 1, r, F.lane); continue; } r -= I_13;
        if (r < I_13) { cvt_item(w3, DM, FF, ffn_norm, (bf16_t*)(ws + WS_W13), 2, r, F.lane); continue; } r -= I_13;
        cvt_item(w2, FF, DM, nullptr, (bf16_t*)(ws + WS_W2), 0, r, F.lane);
    }
    const float* x = a.in[0]; bf16_t* HB = (bf16_t*)(ws + WS_HB); float* ssp = (float*)(ws + WS_SSP);
    for (int m = gw; m < M; m += NGW) {
        const f32x4* xr = (const f32x4*)(x + (size_t)m * DM) + F.lane; f32x4 v[4]; float s = 0.f;
#pragma unroll
        for (int j = 0; j < 4; ++j) { v[j] = xr[64 * j]; s += (v[j][0] * v[j][0] + v[j][1] * v[j][1]) + (v[j][2] * v[j][2] + v[j][3] * v[j][3]); }
        s = wave_sum(s);
        u32x2* o8 = (u32x2*)(HB + (size_t)m * DM) + F.lane;
#pragma unroll
        for (int j = 0; j < 4; ++j) { u32x2 w; w.x = cvtpk(v[j][0], v[j][1]); w.y = cvtpk(v[j][2], v[j][3]); o8[64 * j] = w; }
        if (F.lane < 16) ssp[(size_t)m * 16 + F.lane] = F.lane == 0 ? s : 0.f;
    }
}
__device__ __forceinline__ void kmean_phase(const Frame& F, const bf16_t* Kb, float* km) {
    const int gw = F.vcu * NWAVES + F.wave, NGW = F.G * NWAVES;
    for (int it = gw; it < NB * NH * 8; it += NGW) {
        const int n = it & 7, bh = it >> 3, b = bh >> 4, h = bh & 15;
        const bf16_t* src = Kb + ((size_t)b * SEQ + 256 * n + (F.lane >> 3)) * DM + h * HD + (F.lane & 7) * 8;
        float s[8];
#pragma unroll
        for (int j = 0; j < 8; ++j) s[j] = 0.f;
#pragma unroll 8
        for (int p = 0; p < 32; ++p) { const bf16x8 v = *(const bf16x8*)(src + (size_t)p * 8 * DM);
#pragma unroll
            for (int j = 0; j < 8; ++j) s[j] += bf2f((unsigned short)v[j]); }
#pragma unroll
        for (int j = 0; j < 8; ++j) { s[j] += __shfl_xor(s[j], 8); s[j] += __shfl_xor(s[j], 16); s[j] += __shfl_xor(s[j], 32); }
        if (F.lane < 8) { float* o = km + (size_t)it * 64 + F.lane * 8;
#pragma unroll
            for (int j = 0; j < 8; ++j) o[j] = s[j] * (1.0f / 256.0f); }
    }
}
__device__ __forceinline__ void router_phase(const Frame& F, const Args& a) {
    unsigned char* ws = a.ws; const float* hres = a.out; const float* router = a.in[9]; const float* g = a.in[4] + DM;
    LAS float* rw = (LAS float*)(F.lds);
    LAS int* cnt = (LAS int*)(F.lds + 32768);
    for (int i = F.tid; i < DM * NE; i += NWAVES * 64) rw[i] = router[i] * g[i >> 3];
    if (F.tid < NE) cnt[F.tid] = 0;
    __syncthreads();
    int* tok_e = (int*)(ws + WS_TOKE); float* tok_g = (float*)(ws + WS_TOKG); float* rstd_t = (float*)(ws + WS_RSTD);
    const int c = blockIdx.x;
    for (int i = 0; i < 8; ++i) {
        const int row = 64 * c + 8 * F.wave + i;
        if (row >= M) break;
        const float* hr = hres + (size_t)row * DM;
        float lg[8]; float ss = 0.f;
#pragma unroll
        for (int e = 0; e < 8; ++e) lg[e] = 0.f;
#pragma unroll
        for (int j = 0; j < 16; ++j) { const int k = F.lane + 64 * j; const float hv = hr[k]; ss += hv * hv;
            const LAS f32x4* rp = (const LAS f32x4*)(rw + k * 8); const f32x4 r0 = rp[0], r1 = rp[1];
            lg[0] += hv * r0[0]; lg[1] += hv * r0[1]; lg[2] += hv * r0[2]; lg[3] += hv * r0[3]; lg[4] += hv * r1[0]; lg[5] += hv * r1[1]; lg[6] += hv * r1[2]; lg[7] += hv * r1[3]; }
        ss = wave_sum(ss); const float rstd = 1.0f / sqrtf(ss * (1.0f / DM) + RMS_EPS);
#pragma unroll
        for (int e = 0; e < 8; ++e) lg[e] = wave_sum(lg[e]) * rstd;
        int e1 = 0; float v1 = lg[0];
#pragma unroll
        for (int e = 1; e < 8; ++e) if (lg[e] > v1) { v1 = lg[e]; e1 = e; }
        int e2 = -1; float v2 = -INFINITY;
#pragma unroll
        for (int e = 0; e < 8; ++e) if (e != e1 && (e2 < 0 || lg[e] > v2)) { v2 = lg[e]; e2 = e; }
        const float ex = __expf(v2 - v1); const float w1 = 1.0f / (1.0f + ex), w2 = ex / (1.0f + ex);
        if (F.lane == 0) { tok_e[2 * row] = e1; tok_e[2 * row + 1] = e2; tok_g[2 * row] = w1; tok_g[2 * row + 1] = w2; rstd_t[row] = rstd;
            __hip_atomic_fetch_add(&cnt[e1], 1, __ATOMIC_RELAXED, __HIP_MEMORY_SCOPE_WORKGROUP); __hip_atomic_fetch_add(&cnt[e2], 1, __ATOMIC_RELAXED, __HIP_MEMORY_SCOPE_WORKGROUP); }
    }
    __syncthreads();
    if (F.tid < NE && c < 256) ((int*)(ws + WS_HIST))[c * 8 + F.tid] = cnt[F.tid];
    __syncthreads();
}
__device__ __forceinline__ void assign_phase(const Frame& F, const Args& a) {
    unsigned char* ws = a.ws;
    LAS int* H = (LAS int*)(F.lds);
    LAS int* tot = H + 2048; LAS int* bef = tot + 8; LAS int* tst = bef + 8; LAS int* ntl = tst + 16;
    const int c = blockIdx.x;
    const int* hist = (const int*)(ws + WS_HIST);
    for (int i = F.tid; i < 2048; i += NWAVES * 64) H[i] = __hip_atomic_load(hist + i, __ATOMIC_RELAXED, __HIP_MEMORY_SCOPE_AGENT);
    __syncthreads();
    if (F.tid < NE) { int t = 0, bb = 0; for (int b2 = 0; b2 < 256; ++b2) { const int v = H[b2 * 8 + F.tid]; if (b2 < c) bb += v; t += v; } tot[F.tid] = t; bef[F.tid] = bb; }
    __syncthreads();
    if (F.tid == 0) { int s = 0; for (int e = 0; e < NE; ++e) { const int nt = (tot[e] + 255) >> 8; tst[e] = s; ntl[e] = nt; s += nt; } tst[8] = s; }
    __syncthreads();
    const int* tok_e = (const int*)(ws + WS_TOKE); int* tok_s = (int*)(ws + WS_TOKS); const float* rstd_t = (const float*)(ws + WS_RSTD);
    int* rowidx = (int*)(ws + WS_ROWIDX); float* rslot = (float*)(ws + WS_RSLOT);
    if (F.tid < NE && c < 256) { const int e = F.tid; int pos = 256 * tst[e] + bef[e];
        for (int i = 0; i < 64; ++i) { const int row = 64 * c + i;
            for (int k = 0; k < 2; ++k) if (tok_e[2 * row + k] == e) { rowidx[pos] = row; rslot[pos] = rstd_t[row]; tok_s[2 * row + k] = pos; ++pos; } } }
    if (c < NE) { const int e = c; const int lo = 256 * tst[e] + tot[e], hi2 = 256 * (tst[e] + ntl[e]);
        for (int s = lo + F.tid; s < hi2; s += NWAVES * 64) { rowidx[s] = 0; rslot[s] = 0.f; } }
    if (c == 0) { int* tile_e = (int*)(ws + WS_TILEE);
        if (F.tid < MAXT) { int e = 0; for (int q = 0; q < NE; ++q) if (F.tid >= tst[q] && F.tid < tst[q] + ntl[q]) e = q; tile_e[F.tid] = e; }
        if (F.tid == 0) *(int*)(ws + WS_NTIL) = tst[8]; }
    __syncthreads();
}
__device__ __forceinline__ void combine_phase(const Frame& F, const Args& a, bool poison) {
    unsigned char* ws = a.ws; float* out = a.out; const float* gfin = a.in[13];
    const int* tok_s = (const int*)(ws + WS_TOKS); const float* tok_g = (const float*)(ws + WS_TOKG); const bf16_t* Y = (const bf16_t*)(ws + WS_Y);
    const int gw = F.vcu * NWAVES + F.wave, NGW = F.G * NWAVES;
    f32x4 gf[4];
#pragma unroll
    for (int j = 0; j < 4; ++j) gf[j] = ((const f32x4*)gfin)[F.lane + 64 * j];
    for (int m = gw; m < M; m += NGW) {
        const int s1 = tok_s[2 * m], s2 = tok_s[2 * m + 1]; const float w1 = tok_g[2 * m], w2 = tok_g[2 * m + 1];
        f32x4* hr = (f32x4*)(out + (size_t)m * DM) + F.lane;
        const u32x2* y1 = (const u32x2*)(Y + (size_t)s1 * DM) + F.lane; const u32x2* y2 = (const u32x2*)(Y + (size_t)s2 * DM) + F.lane;
        f32x4 v[4]; float ss = 0.f;
#pragma unroll
        for (int j = 0; j < 4; ++j) { const f32x4 hv = hr[64 * j]; const u32x2 a1 = y1[64 * j], a2 = y2[64 * j];
            v[j][0] = hv[0] + w1 * __uint_as_float(a1.x << 16) + w2 * __uint_as_float(a2.x << 16);
            v[j][1] = hv[1] + w1 * __uint_as_float(a1.x & 0xffff0000u) + w2 * __uint_as_float(a2.x & 0xffff0000u);
            v[j][2] = hv[2] + w1 * __uint_as_float(a1.y << 16) + w2 * __uint_as_float(a2.y << 16);
            v[j][3] = hv[3] + w1 * __uint_as_float(a1.y & 0xffff0000u) + w2 * __uint_as_float(a2.y & 0xffff0000u);
            ss += (v[j][0] * v[j][0] + v[j][1] * v[j][1]) + (v[j][2] * v[j][2] + v[j][3] * v[j][3]); }
        ss = wave_sum(ss); float rstd = 1.0f / sqrtf(ss * (1.0f / DM) + RMS_EPS);
        if (poison) rstd = __builtin_nanf("");
#pragma unroll
        for (int j = 0; j < 4; ++j) hr[64 * j] = v[j] * rstd * gf[j];
    }
}

__global__ void __launch_bounds__(NWAVES * 64, 2) mega_fwd(Args args) {
    extern __shared__ __attribute__((aligned(16))) unsigned char lds[];
    Frame F;
    F.lds = (LAS unsigned char*)lds;
    F.tid = threadIdx.x; F.lane = F.tid & 63; F.wave = __builtin_amdgcn_readfirstlane(F.tid >> 6);
    F.G = gridDim.x; { const int bx = blockIdx.x; F.vcu = (F.G % 8 == 0) ? (bx % 8) * (F.G / 8) + bx / 8 : bx; }
    unsigned char* ws = args.ws;
    gu32* ctl = (gu32*)(ws + WS_CTL);
    for (int u = F.tid; u < (LDS_BYTES - LDSCTL_OFF) / 4; u += NWAVES * 64) ((LAS unsigned*)(F.lds + LDSCTL_OFF))[u] = 0u;
    __syncthreads();
    XcdBarrier bar = xcd_barrier_post((unsigned*)(ctl + CW_BAR), (volatile LAS unsigned*)(F.lds + MISC_OFF) + 8);
#define GRID_BAR() xcd_barrier(bar)
    bf16_t* HB = (bf16_t*)(ws + WS_HB); float* ssp = (float*)(ws + WS_SSP);
    bf16_t* QO = (bf16_t*)(ws + WS_QO); bf16_t* KB = (bf16_t*)(ws + WS_K); bf16_t* VB = (bf16_t*)(ws + WS_V);
    LAS unsigned char* ring = F.lds + RING_OFF;
    const int bx = (int)blockIdx.x;

    p0_prologue(F, args);
#if PROBE == 1
    GRID_BAR(); p0_prologue(F, args);
#endif
    GRID_BAR();
    {
        pg8::Gemm g{HB, (const bf16_t*)(ws + WS_WQKV0), M, NQKV, DM, nullptr, nullptr, 0}; pg8::StaticOrder S; S.init(M, NQKV, F.G, bx);
        pg8::EpiBf16<16> E{QO, DM, DM, (size_t)(WS_K - WS_QO) / 2, C2, ssp};
        pg8::gemm_phase<pg8::EpiBf16<16>, false, false>(ring, g, S, E);
    }
    GRID_BAR();
    {
        ExpCvt C{args.in[10], args.in[11], args.in[12], args.in[4] + DM, (bf16_t*)(ws + WS_E13), (bf16_t*)(ws + WS_E2), F.vcu * NWAVES + F.wave, F.G * NWAVES};
        for (int i = 0; i < 4; ++i) { const int uid = F.vcu * 4 + i; if (uid >= NB * NH * 8) break; const int bh = uid >> 3, qb = uid & 7;
            att::sb_unit(bh >> 4, bh & 15, qb, QO, KB, VB, QO, (LAS char*)ring, C); }
        for (; C.next < N_EXP_ITEMS; C.next += C.stride) { const ExpJob j = exp_decode(C, C.next); cvt_item(j.W, j.K, j.N, j.g, j.WT, j.mode, j.item, F.lane); }
    }
    GRID_BAR();
    {
        pg8::Gemm g{QO, (const bf16_t*)(ws + WS_WO0), M, DM, DM, nullptr, nullptr, 0}; pg8::StaticOrder S; S.init(M, DM, F.G, bx);
        pg8::EpiRes E{args.in[0], args.out, HB, ssp};
        pg8::gemm_phase<pg8::EpiRes, false, false>(ring, g, S, E);
    }
    GRID_BAR();
    {
        pg8::Gemm g{HB, (const bf16_t*)(ws + WS_W13), M, 2 * FF, DM, nullptr, nullptr, 0}; pg8::StaticOrder S; S.init(M, 2 * FF, F.G, bx);
        pg8::EpiSwiglu<16> E{(bf16_t*)(ws + WS_HID0), FF, ssp};
        pg8::gemm_phase<pg8::EpiSwiglu<16>, false, false>(ring, g, S, E);
    }
    GRID_BAR();
    {
        pg8::Gemm g{(const bf16_t*)(ws + WS_HID0), (const bf16_t*)(ws + WS_W2), M, DM, FF, nullptr, nullptr, 0}; pg8::StaticOrder S; S.init(M, DM, F.G, bx);
        pg8::EpiRes E{args.out, args.out, HB, ssp};
        pg8::gemm_phase<pg8::EpiRes, false, false>(ring, g, S, E);
    }
    GRID_BAR();
    {
        pg8::Gemm g{HB, (const bf16_t*)(ws + WS_WQKV1), M, NQKV, DM, nullptr, nullptr, 0}; pg8::StaticOrder S; S.init(M, NQKV, F.G, bx);
        pg8::EpiBf16<16> E{QO, DM, DM, (size_t)(WS_K - WS_QO) / 2, C2, ssp};
        pg8::gemm_phase<pg8::EpiBf16<16>, false, false>(ring, g, S, E);
    }
    GRID_BAR();
    kmean_phase(F, KB, (float*)(ws + WS_KM));
#if PROBE == 6
    kmean_phase(F, KB, (float*)(ws + WS_KM));
#endif
#if PROBE == 7
    GRID_BAR(); GRID_BAR(); GRID_BAR(); GRID_BAR(); GRID_BAR(); GRID_BAR(); GRID_BAR(); GRID_BAR();
#endif
    GRID_BAR();
    {
        if (F.G == 256) { const int bh = F.vcu >> 1, hf = F.vcu & 1;
#if PROBE == 5
            for (int i = 0; i < 4; ++i) { const int own = hf ? (i == 0 ? 1 : i == 1 ? 6 : i == 2 ? 2 : 5) : (i == 0 ? 0 : i == 1 ? 7 : i == 2 ? 3 : 4);
                att::moba_fast<8>(bh >> 4, bh & 15, own, QO, KB, VB, (bf16_t*)(ws + 340 * MiB), (const float*)(ws + WS_KM), args.in[5], (LAS char*)ring); }
#endif
            for (int i = 0; i < 4; ++i) { const int own = hf ? (i == 0 ? 1 : i == 1 ? 6 : i == 2 ? 2 : 5) : (i == 0 ? 0 : i == 1 ? 7 : i == 2 ? 3 : 4);
                att::moba_fast<8>(bh >> 4, bh & 15, own, QO, KB, VB, QO, (const float*)(ws + WS_KM), args.in[5], (LAS char*)ring); } }
    }
    GRID_BAR();
    {
        pg8::Gemm g{QO, (const bf16_t*)(ws + WS_WO1), M, DM, DM, nullptr, nullptr, 0}; pg8::StaticOrder S; S.init(M, DM, F.G, bx);
        pg8::EpiRes E{args.out, args.out, HB, ssp};
        pg8::gemm_phase<pg8::EpiRes, false, false>(ring, g, S, E);
    }
    GRID_BAR();
    if (F.G == 256) router_phase(F, args);
    GRID_BAR();
    if (F.G == 256) assign_phase(F, args);
    GRID_BAR();
#if PROBE == 6
    if (F.G == 256) router_phase(F, args);
    GRID_BAR();
    if (F.G == 256) assign_phase(F, args);
    GRID_BAR();
#endif
    const int ntiles = __builtin_amdgcn_readfirstlane(__hip_atomic_load((int*)(ws + WS_NTIL), __ATOMIC_RELAXED, __HIP_MEMORY_SCOPE_AGENT));
    {
        pg8::Gemm g{HB, (const bf16_t*)(ws + WS_E13), ntiles * 256, 2 * FE, DM, (const int*)(ws + WS_ROWIDX), (const int*)(ws + WS_TILEE), (size_t)2 * FE * DM}; pg8::StaticOrder S; S.init(ntiles * 256, 2 * FE, F.G, bx);
        pg8::EpiSwiglu<1> E{(bf16_t*)(ws + WS_H), FE, (const float*)(ws + WS_RSLOT)};
        pg8::gemm_phase<pg8::EpiSwiglu<1>, true, true>(ring, g, S, E);
#if PROBE == 2
        GRID_BAR(); pg8::gemm_phase<pg8::EpiSwiglu<1>, true, true>(ring, g, S, E);
#endif
    }
    GRID_BAR();
    {
        pg8::Gemm g{(const bf16_t*)(ws + WS_H), (const bf16_t*)(ws + WS_E2), ntiles * 256, DM, FE, nullptr, (const int*)(ws + WS_TILEE), (size_t)DM * FE}; pg8::StaticOrder S; S.init(ntiles * 256, DM, F.G, bx);
        pg8::EpiBf16<1> E{(bf16_t*)(ws + WS_Y), DM, 0, 0, 1.f, nullptr};
        pg8::gemm_phase<pg8::EpiBf16<1>, false, true>(ring, g, S, E);
#if PROBE == 3
        GRID_BAR(); pg8::gemm_phase<pg8::EpiBf16<1>, false, true>(ring, g, S, E);
#endif
    }
    GRID_BAR();
    {
        bool poison = (__hip_atomic_load(ctl + CW_BAR + XB_TMO, __ATOMIC_RELAXED, __HIP_MEMORY_SCOPE_AGENT) != 0u) || (F.G != 256);
        combine_phase(F, args, poison);
    }
}

extern "C" void kernel_launch(void* const* d_in, const int* in_sizes, int n_in, void* d_out, int out_size, void* d_ws, size_t ws_size, hipStream_t stream) {
    static int grid = 0;
    if (grid == 0) {
        if (n_in != 14 || in_sizes[0] != M * DM || out_size != M * DM || ws_size < WS_END) { fprintf(stderr, "kernel_launch: unexpected shapes or workspace (%zu < %zu); nothing launched\n", ws_size, (size_t)WS_END); grid = -1; return; }
        int dev = 0, cus = 0, per_cu = 0;
        if (hipGetDevice(&dev) != hipSuccess || hipDeviceGetAttribute(&cus, hipDeviceAttributeMultiprocessorCount, dev) != hipSuccess) { grid = -1; return; }
        if (hipFuncSetAttribute((const void*)mega_fwd, hipFuncAttributeMaxDynamicSharedMemorySize, LDS_BYTES) != hipSuccess) { fprintf(stderr, "kernel_launch: hipFuncSetAttribute failed\n"); grid = -1; return; }
        if (hipOccupancyMaxActiveBlocksPerMultiprocessor(&per_cu, (const void*)mega_fwd, NWAVES * 64, LDS_BYTES) != hipSuccess || per_cu < 1) { fprintf(stderr, "kernel_launch: occupancy query reports %d\n", per_cu); }
        (void)hipGetLastError();
        grid = cus;
    }
    if (grid < 0) return;
    if (hipMemsetAsync((char*)d_ws + WS_CTL, 0, CTL_ZERO_BYTES, stream) != hipSuccess) return;
    Args a{};
    for (int i = 0; i < 14; ++i) a.in[i] = (const float*)d_in[i];
    a.out = (float*)d_out; a.ws = (unsigned char*)d_ws;
    hipLaunchKernelGGL(mega_fwd, dim3(grid), dim3(NWAVES * 64), LDS_BYTES, stream, a);
}
```
